# Optimizing an MI355X kernel written in HIP

```python
import jax, jax.numpy as jnp
from jax import lax
import numpy as np

D_MODEL = 1024
BATCH = 16
SEQ = 2048
DEPTH = 4

N_MIXERS = 2
N_META = 16
N_HEADS = 16
QK_NOPE_DIM = 64
QK_ROPE_DIM = 32
QK_HEAD_DIM = QK_NOPE_DIM + QK_ROPE_DIM
V_HEAD_DIM = 64
Q_LORA_RANK = 384
KV_LORA_RANK = 256
ROPE_THETA = 10000.0
Q_BLOCK = 128
POOL_WINDOWS = (2, 4, 8, 16)
N_POOL_GROUPS = len(POOL_WINDOWS)
POOL_GROUP_DIM = D_MODEL // N_POOL_GROUPS
D_FF = 2816
CONV_WIDTH = 3
NORM_EPS = 1e-6
N_MLA_LAYERS = len(range(0, DEPTH, N_MIXERS))
N_POOL_LAYERS = DEPTH - N_MLA_LAYERS

kernel_name = "hybrid_mla_multiscale_pool_convffn"


def rmsnorm(x, g):
    xf = x.astype(jnp.float32)
    y = xf * lax.rsqrt(jnp.mean(xf * xf, axis=-1, keepdims=True) + NORM_EPS)
    return (y * g.astype(jnp.float32)).astype(x.dtype)


def rope_tables(length):
    inv = 1.0 / (ROPE_THETA ** (jnp.arange(0, QK_ROPE_DIM, 2, dtype=jnp.float32) / QK_ROPE_DIM))
    ang = jnp.arange(length, dtype=jnp.float32)[:, None] * inv[None, :]
    return jnp.cos(ang), jnp.sin(ang)


def apply_rope(x, cos, sin):
    xf = x.astype(jnp.float32)
    x1, x2 = jnp.split(xf, 2, axis=-1)
    c = cos[None, :, None, :]
    s = sin[None, :, None, :]
    return jnp.concatenate([x1 * c - x2 * s, x2 * c + x1 * s], axis=-1).astype(x.dtype)


def mla_mixer(h, w_dqkv, q_norm, w_uq, kv_norm, w_ukv, w_o, cos, sin):
    B, L, _ = h.shape
    a = h @ w_dqkv
    c_q, c_kv, k_rope = jnp.split(a, [Q_LORA_RANK, Q_LORA_RANK + KV_LORA_RANK], axis=-1)
    c_q = rmsnorm(c_q, q_norm)
    c_kv = rmsnorm(c_kv, kv_norm)
    q = (c_q @ w_uq).reshape(B, L, N_HEADS, QK_HEAD_DIM)
    q = jnp.concatenate([q[..., :QK_NOPE_DIM], apply_rope(q[..., QK_NOPE_DIM:], cos, sin)], axis=-1)
    kv = (c_kv @ w_ukv).reshape(B, L, N_HEADS, QK_NOPE_DIM + V_HEAD_DIM)
    k_nope, v = jnp.split(kv, [QK_NOPE_DIM], axis=-1)
    k_rope = apply_rope(k_rope[:, :, None, :], cos, sin)
    k = jnp.concatenate([k_nope, jnp.broadcast_to(k_rope, (B, L, N_HEADS, QK_ROPE_DIM))], axis=-1)
    scale = QK_HEAD_DIM ** -0.5
    outs = []
    for start in range(0, L, Q_BLOCK):
        end = start + Q_BLOCK
        qb = q[:, start:end]
        kb = k[:, :end]
        vb = v[:, :end]
        s = jnp.einsum('bqhd,bkhd->bhqk', qb, kb).astype(jnp.float32) * scale
        mask = jnp.arange(start, end)[:, None] >= jnp.arange(end)[None, :]
        s = jnp.where(mask[None, None], s, -jnp.inf)
        p = jax.nn.softmax(s, axis=-1).astype(vb.dtype)
        outs.append(jnp.einsum('bhqk,bkhd->bqhd', p, vb))
    o = jnp.concatenate(outs, axis=1).reshape(B, L, N_HEADS * V_HEAD_DIM)
    return o @ w_o


def pool_mixer(h, w_group, scale):
    B, L, D = h.shape
    hf = h.astype(jnp.float32).reshape(B, L, N_POOL_GROUPS, POOL_GROUP_DIM)
    csum = jnp.cumsum(hf, axis=1)
    t = jnp.arange(1, L + 1, dtype=jnp.float32)
    means = []
    for g, w in enumerate(POOL_WINDOWS):
        cg = csum[:, :, g, :]
        prev = jnp.pad(cg[:, :L - w], ((0, 0), (w, 0), (0, 0)))
        cnt = jnp.minimum(t, float(w))[None, :, None]
        means.append((cg - prev) / cnt)
    pooled = jnp.stack(means, axis=2)
    mixed = (pooled - hf).astype(h.dtype)
    y = jnp.einsum('blgc,gcd->blgd', mixed, w_group).reshape(B, L, D)
    return y * scale


def conv_ffn(h, w_up, conv_w, conv_b, w_down):
    L = h.shape[1]
    u = h @ w_up
    up = jnp.pad(u, ((0, 0), (CONV_WIDTH - 1, 0), (0, 0)))
    u = conv_b + sum(conv_w[j] * up[:, j:j + L] for j in range(CONV_WIDTH))
    gate, val = jnp.split(u, 2, axis=-1)
    return (jax.nn.silu(gate) * val) @ w_down


def setup_inputs(seed: int = 0) -> dict:
    key = jax.random.key(seed)
    ks = jax.random.split(key, 24)
    f32 = jnp.float32

    def nrm(k, shape, fan_in):
        return jax.random.normal(k, shape, f32) * (fan_in ** -0.5)

    def gain(k, shape, s=0.05):
        return 1.0 + s * jax.random.normal(k, shape, f32)

    return {
        "x": jax.random.normal(ks[0], (BATCH, SEQ, D_MODEL), f32),
        "meta_tokens": jax.random.normal(ks[1], (N_META, D_MODEL), f32),
        "norm_mix_pre": gain(ks[2], (DEPTH, D_MODEL)),
        "norm_mix_post": gain(ks[3], (DEPTH, D_MODEL)),
        "norm_ffn_pre": gain(ks[4], (DEPTH, D_MODEL)),
        "norm_ffn_post": gain(ks[5], (DEPTH, D_MODEL)),
        "mla_w_dqkv": nrm(ks[6], (N_MLA_LAYERS, D_MODEL, Q_LORA_RANK + KV_LORA_RANK + QK_ROPE_DIM), D_MODEL),
        "mla_q_norm": gain(ks[7], (N_MLA_LAYERS, Q_LORA_RANK)),
        "mla_w_uq": nrm(ks[8], (N_MLA_LAYERS, Q_LORA_RANK, N_HEADS * QK_HEAD_DIM), Q_LORA_RANK),
        "mla_kv_norm": gain(ks[9], (N_MLA_LAYERS, KV_LORA_RANK)),
        "mla_w_ukv": nrm(ks[10], (N_MLA_LAYERS, KV_LORA_RANK, N_HEADS * (QK_NOPE_DIM + V_HEAD_DIM)), KV_LORA_RANK),
        "mla_w_o": nrm(ks[11], (N_MLA_LAYERS, N_HEADS * V_HEAD_DIM, D_MODEL), N_HEADS * V_HEAD_DIM),
        "pool_w_group": nrm(ks[12], (N_POOL_LAYERS, N_POOL_GROUPS, POOL_GROUP_DIM, POOL_GROUP_DIM), POOL_GROUP_DIM),
        "pool_scale": gain(ks[13], (N_POOL_LAYERS, D_MODEL), 0.1),
        "ffn_w_up": nrm(ks[14], (DEPTH, D_MODEL, 2 * D_FF), D_MODEL),
        "ffn_conv_w": nrm(ks[15], (DEPTH, CONV_WIDTH, 2 * D_FF), CONV_WIDTH),
        "ffn_conv_b": 0.01 * jax.random.normal(ks[16], (DEPTH, 2 * D_FF), f32),
        "ffn_w_down": nrm(ks[17], (DEPTH, D_FF, D_MODEL), D_FF),
    }


def reference(x, meta_tokens, norm_mix_pre, norm_mix_post, norm_ffn_pre, norm_ffn_post,
              mla_w_dqkv, mla_q_norm, mla_w_uq, mla_kv_norm, mla_w_ukv, mla_w_o,
              pool_w_group, pool_scale, ffn_w_up, ffn_conv_w, ffn_conv_b, ffn_w_down):
    B, S, D = x.shape
    L = N_META + S
    L_pad = -(-L // Q_BLOCK) * Q_BLOCK
    meta = jnp.broadcast_to(meta_tokens.astype(x.dtype)[None], (B, N_META, D))
    h = jnp.concatenate([meta, x, jnp.zeros((B, L_pad - L, D), x.dtype)], axis=1)
    cos, sin = rope_tables(L_pad)
    for i in range(DEPTH):
        j = i // N_MIXERS
        a = rmsnorm(h, norm_mix_pre[i])
        if i % N_MIXERS == 0:
            m = mla_mixer(a, mla_w_dqkv[j], mla_q_norm[j], mla_w_uq[j], mla_kv_norm[j],
                          mla_w_ukv[j], mla_w_o[j], cos, sin)
        else:
            m = pool_mixer(a, pool_w_group[j], pool_scale[j])
        h = h + rmsnorm(m, norm_mix_post[i])
        f = conv_ffn(rmsnorm(h, norm_ffn_pre[i]), ffn_w_up[i], ffn_conv_w[i], ffn_conv_b[i], ffn_w_down[i])
        h = h + rmsnorm(f, norm_ffn_post[i])
    return h[:, N_META:L]
```

```cpp
#include <hip/hip_runtime.h>
#include <hip/hip_cooperative_groups.h>
#include <cstdio>
#include <cstdint>
namespace cg = cooperative_groups;

namespace pg8 {
#define PG8_LAS __attribute__((address_space(3)))
typedef unsigned short bf16_t;
typedef short bf16x8 __attribute__((ext_vector_type(8)));
typedef float f32x4 __attribute__((ext_vector_type(4)));
typedef unsigned u32x4 __attribute__((ext_vector_type(4)));
constexpr int BM = 256, BK = 64, HALF = 128, HTB = HALF * BK * 2  , STAGE_BYTES = 8 * HTB, NXCD = 8, WGM = 8;

__host__ __device__ __forceinline__ int lds_byte(int r, int c) { const int st = (r >> 4) * 2 + (c >> 5), rr = r & 15, cc = c & 31, ob = rr * 64 + cc * 2; return st * 1024 + (ob ^ (((ob >> 9) & 1) << 5)); }
__host__ __device__ __forceinline__ void stage_rc(int b, int& R, int& C) { const int st = b / 1024, sb = b % 1024, swz = sb ^ (((sb >> 9) & 1) << 5); R = (st >> 1) * 16 + swz / 64; C = (st & 1) * 32 + (swz % 64) / 2; }
__host__ __device__ __forceinline__ int perm32(int rho) { const int n = rho >> 4, i = rho & 15; return 8 * (i >> 2) + 4 * n + (i & 3); }

struct Unit { int pm, pn; };
struct Gemm { const bf16_t* A; const bf16_t* Bt; int K, lda, a_row0, a_rstep, a_pn_bytes, ldb; };

struct StaticOrder {
    int nM, nN, nwg, G, c, wgm;
    __host__ __device__ void init(int M, int N, int G_, int c_, int wgm_ = WGM) { nM = M / BM; nN = N / BM; nwg = nM * nN; G = G_; c = c_; wgm = wgm_; }
    __host__ __device__ bool next(int i, Unit& u) const {
        const long L = (long)i * G + c; if (L >= nwg) return false;
        int wgid = (int)L; { const int q = nwg / NXCD, r = nwg % NXCD, xcd = wgid % NXCD, off = wgid / NXCD; wgid = (xcd < r ? xcd * (q + 1) : r * (q + 1) + (xcd - r) * q) + off; }
        const int nig = wgm * nN, gid = wgid / nig, fm = gid * wgm, gsz = (nM - fm) < wgm ? (nM - fm) : wgm;
        u.pm = fm + ((wgid % nig) % gsz); u.pn = (wgid % nig) / gsz; return true;
    }
    __device__ __forceinline__ void a_ready(const Unit&) const {}
    __device__ __forceinline__ void done(const Unit&) const {}
};

struct TailOrder {
    int pm, nN, c;
    __device__ __forceinline__ bool next(int i, Unit& u) const { if (i > 0 || c >= nN) return false; u.pm = pm; u.pn = c; return true; }
    __device__ __forceinline__ void a_ready(const Unit&) const {}
    __device__ __forceinline__ void done(const Unit&) const {}
};

__device__ __forceinline__ unsigned cvt_pk_bf16(float lo, float hi) { unsigned r; asm volatile("v_cvt_pk_bf16_f32 %0, %1, %2" : "=v"(r) : "v"(lo), "v"(hi)); return r; }

typedef unsigned u32x2 __attribute__((ext_vector_type(2)));

struct EpiStore {
    static constexpr bool PERM = true, AFTER_DRAIN = false, ROWPERM = false, PREFETCH = false;
    bf16_t* O; int ldc; const float* rs; float rsdiv; const bf16_t* kr_src; bf16_t* kr_dst; const float* rcos; int seqlen;
    __device__ __forceinline__ void operator()(const f32x4 (&acc)[2][2][4][2], const Unit& u, int wr, int wc, int fr_, int fq_) const {
        (void)fr_; (void)fq_; int l_; asm volatile("v_mbcnt_lo_u32_b32 %0, -1, 0\n\tv_mbcnt_hi_u32_b32 %0, -1, %0" : "=v"(l_));
        const int fr = l_ & 15, fq = l_ >> 4;
        const int row0 = u.pm * BM + wr * 64 + fr; const int col0 = u.pn * BM + wc * 32 + 8 * fq;
#pragma unroll
        for (int ai = 0; ai < 2; ++ai)
#pragma unroll
            for (int m = 0; m < 4; ++m) { bf16_t* rowp = O + (size_t)(row0 + ai * HALF + m * 16) * ldc + col0; float sc = 1.0f;
                if (rsdiv > 0.f) { const float* pp = rs + (size_t)(row0 + ai * HALF + m * 16) * 20 + 12; const f32x4 pa = *(const f32x4*)pp, pb = *(const f32x4*)(pp + 4);
                    sc = 1.0f / sqrtf((((pa[0] + pa[1]) + (pa[2] + pa[3])) + ((pb[0] + pb[1]) + (pb[2] + pb[3]))) / rsdiv + 1e-6f); }
                else if (rs) sc = rs[row0 + ai * HALF + m * 16];
#pragma unroll
                for (int bj = 0; bj < 2; ++bj) { const f32x4 v0 = acc[ai][bj][m][0] * sc, v1 = acc[ai][bj][m][1] * sc;
                    u32x4 w; w.x = cvt_pk_bf16(v0[0], v0[1]); w.y = cvt_pk_bf16(v0[2], v0[3]); w.z = cvt_pk_bf16(v1[0], v1[1]); w.w = cvt_pk_bf16(v1[2], v1[3]);
                    *(u32x4*)(rowp + bj * HALF) = w; } }
        if (kr_src && u.pn == 0) {
            const int tid = l_ + 64 * (wr * 4 + wc), row = u.pm * BM + (tid >> 1), i0 = (tid & 1) * 8, t = row % seqlen;
            const bf16_t* sp = kr_src + (size_t)row * 768; bf16_t* dp = kr_dst + (size_t)row * 32; const float* cp = rcos + t * 16; const float* snp = cp + seqlen * 16;
            const u32x4 a4 = *(const u32x4*)(sp + i0), b4 = *(const u32x4*)(sp + 16 + i0);
            const unsigned aw[4] = {a4.x, a4.y, a4.z, a4.w}, bw[4] = {b4.x, b4.y, b4.z, b4.w};
            unsigned o1[4], o2[4];
#pragma unroll
            for (int q = 0; q < 4; ++q) {
                const float x1a = __uint_as_float(aw[q] << 16), x1b = __uint_as_float(aw[q] & 0xffff0000u), x2a = __uint_as_float(bw[q] << 16), x2b = __uint_as_float(bw[q] & 0xffff0000u);
                const float ca = cp[i0 + 2 * q], cb = cp[i0 + 2 * q + 1], sa = snp[i0 + 2 * q], sb = snp[i0 + 2 * q + 1];
                o1[q] = cvt_pk_bf16(x1a * ca - x2a * sa, x1b * cb - x2b * sb); o2[q] = cvt_pk_bf16(x2a * ca + x1a * sa, x2b * cb + x1b * sb); }
            u32x4 w1, w2; w1.x = o1[0]; w1.y = o1[1]; w1.z = o1[2]; w1.w = o1[3]; w2.x = o2[0]; w2.y = o2[1]; w2.z = o2[2]; w2.w = o2[3];
            *(u32x4*)(dp + i0) = w1; *(u32x4*)(dp + 16 + i0) = w2;
        }
    }
};

struct EpiT1 {
    static constexpr bool PERM = true, AFTER_DRAIN = false, ROWPERM = false, PREFETCH = false;
    bf16_t* O; const float* rs; float* ps;
    __device__ __forceinline__ void operator()(const f32x4 (&acc)[2][2][4][2], const Unit& u, int wr, int wc, int fr_, int fq_) const {
        (void)fr_; (void)fq_; int l_; asm volatile("v_mbcnt_lo_u32_b32 %0, -1, 0\n\tv_mbcnt_hi_u32_b32 %0, -1, %0" : "=v"(l_));
        const int fr = l_ & 15, fq = l_ >> 4;
        const int row0 = u.pm * BM + wr * 64 + fr; const int col0 = u.pn * BM + wc * 32 + 8 * fq;
        const int kind0 = u.pn == 2 ? 1 : 0, kind1 = u.pn == 0 ? 0 : (u.pn == 1 ? 1 : 2);
#pragma unroll
        for (int ai = 0; ai < 2; ++ai)
#pragma unroll
            for (int m = 0; m < 4; ++m) { const int row = row0 + ai * HALF + m * 16; bf16_t* rowp = O + (size_t)row * 768 + col0; const float sc = rs[row];
#pragma unroll
                for (int bj = 0; bj < 2; ++bj) { const f32x4 v0 = acc[ai][bj][m][0] * sc, v1 = acc[ai][bj][m][1] * sc;
                    u32x4 w; w.x = cvt_pk_bf16(v0[0], v0[1]); w.y = cvt_pk_bf16(v0[2], v0[3]); w.z = cvt_pk_bf16(v1[0], v1[1]); w.w = cvt_pk_bf16(v1[2], v1[3]);
                    *(u32x4*)(rowp + bj * HALF) = w;
                    float p = v0[0] * v0[0] + v0[1] * v0[1] + v0[2] * v0[2] + v0[3] * v0[3] + v1[0] * v1[0] + v1[1] * v1[1] + v1[2] * v1[2] + v1[3] * v1[3];
                    p += __int_as_float(__builtin_amdgcn_ds_bpermute((l_ ^ 16) << 2, __float_as_int(p)));
                    p += __int_as_float(__builtin_amdgcn_ds_bpermute((l_ ^ 32) << 2, __float_as_int(p)));
                    const int kind = bj == 0 ? kind0 : kind1;
                    const int slot = kind == 0 ? (u.pn == 0 ? bj * 4 + wc : 8 + wc) : 12 + (u.pn == 1 ? wc : 4 + wc);
                    if (fq == 0 && kind < 2) ps[(size_t)row * 20 + slot] = p; } }
    }
};

struct EpiQ {
    static constexpr bool PERM = false, AFTER_DRAIN = false, ROWPERM = false, PREFETCH = false;
    bf16_t* O; const float* rcos; const float* rsin; const float* rs; float sc0; int seqlen;
    __device__ __forceinline__ void operator()(const f32x4 (&acc)[2][2][4][2], const Unit& u, int wr, int wc, int fr, int fq) const {
#pragma unroll
        for (int ai = 0; ai < 2; ++ai)
#pragma unroll
            for (int m = 0; m < 4; ++m) {
                const int row = u.pm * BM + ai * HALF + wr * 64 + m * 16 + fr;
                const f32x4 pa = *(const f32x4*)(rs + (size_t)row * 20), pb = *(const f32x4*)(rs + (size_t)row * 20 + 4), pc = *(const f32x4*)(rs + (size_t)row * 20 + 8);
                const float ssq = ((pa[0] + pa[1]) + (pa[2] + pa[3])) + ((pb[0] + pb[1]) + (pb[2] + pb[3])) + ((pc[0] + pc[1]) + (pc[2] + pc[3]));
                const float sc = sc0 / sqrtf(ssq * (1.0f / 384.0f) + 1e-6f);
                bf16_t* rowp = O + (size_t)row * 1536 + u.pn * BM + wc * 32 + 4 * fq;
                if (u.pn < 4) {
#pragma unroll
                    for (int bj = 0; bj < 2; ++bj)
#pragma unroll
                        for (int n = 0; n < 2; ++n) { const f32x4 v = acc[ai][bj][m][n] * sc; u32x2 w; w.x = cvt_pk_bf16(v[0], v[1]); w.y = cvt_pk_bf16(v[2], v[3]); *(u32x2*)(rowp + bj * HALF + n * 16) = w; }
                } else {
                    const int t = row % seqlen;
                    const f32x4 c4 = *(const f32x4*)(rcos + t * 16 + 4 * fq), s4 = *(const f32x4*)(rsin + t * 16 + 4 * fq);
#pragma unroll
                    for (int bj = 0; bj < 2; ++bj) { const f32x4 x1 = acc[ai][bj][m][0], x2 = acc[ai][bj][m][1];
                        const f32x4 o1 = (x1 * c4 - x2 * s4) * sc, o2 = (x2 * c4 + x1 * s4) * sc;
                        u32x2 w; w.x = cvt_pk_bf16(o1[0], o1[1]); w.y = cvt_pk_bf16(o1[2], o1[3]); *(u32x2*)(rowp + bj * HALF) = w;
                        w.x = cvt_pk_bf16(o2[0], o2[1]); w.y = cvt_pk_bf16(o2[2], o2[3]); *(u32x2*)(rowp + bj * HALF + 16) = w; }
                }
            }
    }
};

struct EpiConv {
    static constexpr bool PERM = true, AFTER_DRAIN = false, ROWPERM = true, PREFETCH = true;
    bf16_t* G; const float* cw; const float* cb; const float* rs; PG8_LAS f32x4* xch; PG8_LAS float* wl2; PG8_LAS float* rsl2; int a_row0, a_rstep, nrows, seqlen;
    static __device__ __forceinline__ int xi(int wr, int wc, int ai, int s, int bj, int n, int fq) { return (((((wr * 4 + wc) * 2 + ai) * 2 + s) * 2 + bj) * 2 + n) * 4 + fq; }
    __device__ __forceinline__ void prefetch(const Unit& u, int par, int wid, int lane_) const {
        (void)lane_; int lane; asm volatile("v_mbcnt_lo_u32_b32 %0, -1, 0\n\tv_mbcnt_hi_u32_b32 %0, -1, %0" : "=v"(lane));
        if (wid < 4) { const int c = lane * 4; const float* sp = (wid < 3 ? cw + wid * 5632 : cb) + (c >> 7) * 2816 + u.pn * 128 + (c & 127);
            __builtin_amdgcn_global_load_lds((const unsigned*)sp, (PG8_LAS unsigned*)(wl2 + par * 1024 + wid * 256), 16, 0, 0); }
        else { int gr = a_row0 + u.pm * a_rstep + (wid - 4) * 64 + lane; gr = gr < 0 ? 0 : (gr < nrows ? gr : nrows - 1);
            __builtin_amdgcn_global_load_lds((const unsigned*)(rs + gr), (PG8_LAS unsigned*)(rsl2 + par * 256 + (wid - 4) * 64), 4, 0, 0); }
    }
    __device__ __forceinline__ void run(f32x4 (&acc)[2][2][4][2], const Unit& u, int wr, int wc, int fr_, int fq_, int par) const {
        (void)fr_; (void)fq_; int l_; asm volatile("v_mbcnt_lo_u32_b32 %0, -1, 0\n\tv_mbcnt_hi_u32_b32 %0, -1, %0" : "=v"(l_));
        const int fr = l_ & 15, fq = l_ >> 4;
        const int lane = fr + 16 * fq;
        const PG8_LAS float* wl = wl2 + par * 1024; const PG8_LAS float* rsl = rsl2 + par * 256;
#pragma unroll
        for (int ai = 0; ai < 2; ++ai)
#pragma unroll
            for (int m = 0; m < 4; ++m) { const float sc = rsl[ai * HALF + wr * 64 + 4 * fr + m];
#pragma unroll
                for (int bj = 0; bj < 2; ++bj)
#pragma unroll
                    for (int n = 0; n < 2; ++n) acc[ai][bj][m][n] = acc[ai][bj][m][n] * sc; }
        if (fr == 15) {
#pragma unroll
            for (int ai = 0; ai < 2; ++ai)
#pragma unroll
                for (int bj = 0; bj < 2; ++bj)
#pragma unroll
                    for (int n = 0; n < 2; ++n) { xch[xi(wr, wc, ai, 0, bj, n, fq)] = acc[ai][bj][2][n]; xch[xi(wr, wc, ai, 1, bj, n, fq)] = acc[ai][bj][3][n]; }
        }
        asm volatile("s_waitcnt lgkmcnt(0)" ::: "memory"); __builtin_amdgcn_s_barrier(); asm volatile("" ::: "memory");
        const int src = (lane & 48) | ((fr + 15) & 15);
        const f32x4 z4 = (f32x4){0.f, 0.f, 0.f, 0.f};
        const PG8_LAS float* wlane = wl + wc * 32 + 8 * fq;
        const int cu = u.pn * 128 + wc * 32;
#pragma unroll
        for (int ai = 0; ai < 2; ++ai) {
            const bool has_prev = (wr | ai) != 0;
            const int swr = wr ^ 1, sai = wr ? ai : 0;
            const int growu = a_row0 + u.pm * a_rstep + ai * HALF + wr * 64;
            const int grow0 = growu + 4 * fr;
            const int tz = ((grow0 % seqlen) + seqlen) % seqlen;
#define PG8_Z0(m_) ((tz + (m_)) == 0 || (tz + (m_)) == seqlen)
#define PG8_Z1(m_) ((tz + (m_)) == 1 || (tz + (m_)) == seqlen + 1)
#define PG8_CONV_RUN(EDGE_) do { \
            _Pragma("unroll") for (int bj = 0; bj < 2; ++bj) { \
                _Pragma("unroll") for (int n = 0; n < 2; ++n) { \
                    const PG8_LAS float* wq = wlane + bj * 128 + 4 * n; \
                    const f32x4 w0 = *(const PG8_LAS f32x4*)(wq), w1 = *(const PG8_LAS f32x4*)(wq + 256), w2 = *(const PG8_LAS f32x4*)(wq + 512), bb = *(const PG8_LAS f32x4*)(wq + 768); \
                    const f32x4 v0 = acc[ai][bj][0][n], v1 = acc[ai][bj][1][n], v2 = acc[ai][bj][2][n], v3 = acc[ai][bj][3][n]; \
                      \
                    const f32x4 h2 = has_prev ? xch[xi(swr, wc, sai, 0, bj, n, fq)] : z4, h3 = has_prev ? xch[xi(swr, wc, sai, 1, bj, n, fq)] : z4; \
                    f32x4 s2, s3; \
                    _Pragma("unroll") for (int j = 0; j < 4; ++j) { const float t2 = v2[j], t3 = v3[j], o2 = h2[j], o3 = h3[j]; \
                        s2[j] = __int_as_float(__builtin_amdgcn_update_dpp(__float_as_int(o2), __float_as_int(t2), 0x111, 0xf, 0xf, false)); \
                        s3[j] = __int_as_float(__builtin_amdgcn_update_dpp(__float_as_int(o3), __float_as_int(t3), 0x111, 0xf, 0xf, false)); } \
                    f32x4 a, b; \
                    a = s2; b = s3; if (EDGE_) { if (PG8_Z0(0)) { a = z4; b = z4; } else if (PG8_Z1(0)) a = z4; } \
                    acc[ai][bj][0][n] = bb + w0 * a + w1 * b + w2 * v0; \
                    a = s3; b = v0; if (EDGE_) { if (PG8_Z0(1)) { a = z4; b = z4; } else if (PG8_Z1(1)) a = z4; } \
                    acc[ai][bj][1][n] = bb + w0 * a + w1 * b + w2 * v1; \
                    a = v0; b = v1; if (EDGE_) { if (PG8_Z0(2)) { a = z4; b = z4; } else if (PG8_Z1(2)) a = z4; } \
                    acc[ai][bj][2][n] = bb + w0 * a + w1 * b + w2 * v2; \
                    a = v1; b = v2; if (EDGE_) { if (PG8_Z0(3)) { a = z4; b = z4; } else if (PG8_Z1(3)) a = z4; } \
                    acc[ai][bj][3][n] = bb + w0 * a + w1 * b + w2 * v3; \
                    asm volatile("" ::: "memory"); \
                    __builtin_amdgcn_sched_barrier(0); \
                } \
            } } while (0)
            if (__builtin_amdgcn_ballot_w64(tz < 2 || tz + 3 >= seqlen) != 0ull) PG8_CONV_RUN(true); else PG8_CONV_RUN(false);
#undef PG8_CONV_RUN
#undef PG8_Z0
#undef PG8_Z1
            char* gb = (char*)(G + (long)growu * 2816 + cu);
#pragma unroll
            for (int m = 0; m < 4; ++m) {
                const int grow = grow0 + m, rl = ai * HALF + wr * 64 + 4 * fr + m;
                if (rl >= 2 && grow < nrows) {
                    u32x4 w; float o[8];
#pragma unroll
                    for (int n = 0; n < 2; ++n)
#pragma unroll
                        for (int j = 0; j < 4; ++j) { const float g = acc[ai][0][m][n][j], x = acc[ai][1][m][n][j]; o[n * 4 + j] = g * __builtin_amdgcn_rcpf(1.0f + __expf(-g)) * x; }
                    w.x = cvt_pk_bf16(o[0], o[1]); w.y = cvt_pk_bf16(o[2], o[3]); w.z = cvt_pk_bf16(o[4], o[5]); w.w = cvt_pk_bf16(o[6], o[7]);
                    *(u32x4*)(gb + (unsigned)(((4 * fr + m) * 2816 + 8 * fq) * 2)) = w;
                }
                __builtin_amdgcn_sched_barrier(0);
            }
        }
    }
};

template <class Epi, class Sched, bool ALIGN_EPI = false, bool SP2 = false>
__device__ __forceinline__ void gemm_phase(PG8_LAS unsigned char* lds, const Gemm g, const Sched& S, const Epi& E, int wid0) {
    int tid_; asm volatile("v_mbcnt_lo_u32_b32 %0, -1, 0\n\tv_mbcnt_hi_u32_b32 %0, -1, %0" : "=v"(tid_)); tid_ += wid0 * 64;
    const int tid = tid_, wid = __builtin_amdgcn_readfirstlane(tid >> 6), lane = tid & 63, wr = wid >> 2, wc = wid & 3, fr = lane & 15, fq = lane >> 4;
    const int K = g.K, nt = K / BK, lda = g.lda, ldb = g.ldb;
    unsigned voffA, voffB;
    { int R, C; stage_rc(tid * 16, R, C); const int Rb = Epi::PERM ? ((R & ~31) + perm32(R & 31)) : R;
        const int Ra = Epi::ROWPERM ? ((R & 64) | ((R & 15) << 2) | ((R >> 4) & 3)) : R;
        voffA = (unsigned)(Ra * lda + C) * 2u; voffB = (unsigned)(Rb * ldb + C) * 2u; }
    const size_t r64voffA = (size_t)64 * lda * 2, r64voffB = (size_t)64 * ldb * 2;
    const size_t kstep = (size_t)(BK * 2);
    const size_t hstepB = (size_t)HALF * ldb * 2, hstepA = (size_t)HALF * lda * 2;
    const size_t tstepB = 2 * hstepB;
#define PG8_APTR(u_) ((const char*)g.A + ((long)g.a_row0 + (long)(u_).pm * g.a_rstep) * (long)lda * 2 + (long)(u_).pn * g.a_pn_bytes)
    const unsigned ldsw = (unsigned)wid * 1024u;
    const int aoff = lds_byte(wr * 64 + fr, fq * 8), boff = lds_byte(wc * 32 + fr, fq * 8);
#define PG8_SA(b, h) (((b) * 2 + (h)) * HTB)
#define PG8_SB(b, h) ((4 + (b) * 2 + (h)) * HTB)
#define PG8_STAGE(bufoff, gbase, voff) do { _Pragma("unroll") for (int _i = 0; _i < 2; ++_i) \
        __builtin_amdgcn_global_load_lds((const unsigned*)((const char*)(gbase) + (size_t)_i * r64##voff + voff), (PG8_LAS unsigned*)(lds + (bufoff) + ldsw + _i * 8192), 16, 0, 0); } while (0)
#define PG8_LDA(dst, b, h) do { _Pragma("unroll") for (int m = 0; m < 4; ++m) _Pragma("unroll") for (int k = 0; k < 2; ++k) dst[m][k] = *(const PG8_LAS bf16x8*)(lds + PG8_SA(b, h) + aoff + m * 2048 + k * 1024); } while (0)
#define PG8_LDB(dst, b, h) do { _Pragma("unroll") for (int n = 0; n < 2; ++n) _Pragma("unroll") for (int k = 0; k < 2; ++k) dst[n][k] = *(const PG8_LAS bf16x8*)(lds + PG8_SB(b, h) + boff + n * 2048 + k * 1024); } while (0)
#define PG8_MMA(ai, bj, At, Bt) do { __builtin_amdgcn_s_setprio(1); _Pragma("unroll") for (int m = 0; m < 4; ++m) _Pragma("unroll") for (int n = 0; n < 2; ++n) _Pragma("unroll") for (int k = 0; k < 2; ++k) \
        acc[ai][bj][m][n] = __builtin_amdgcn_mfma_f32_16x16x32_bf16(Bt[n][k], At[m][k], acc[ai][bj][m][n], 0, 0, 0); __builtin_amdgcn_s_setprio(0); } while (0)
#define PG8_WAIT_V(n) asm volatile("s_waitcnt vmcnt(" #n ")" ::: "memory")
#define PG8_WAIT_L(n) asm volatile("s_waitcnt lgkmcnt(" #n ")" ::: "memory")
#define PG8_BAR __builtin_amdgcn_s_barrier()
#define PG8_SCHED __builtin_amdgcn_sched_barrier(0)
    Unit cur, nxt; int ui = 0;
    if (!S.next(0, cur)) return;
    f32x4 acc[2][2][4][2];
#pragma unroll
    for (int a = 0; a < 2; ++a)
#pragma unroll
        for (int b = 0; b < 2; ++b)
#pragma unroll
            for (int m = 0; m < 4; ++m)
#pragma unroll
                for (int n = 0; n < 2; ++n) acc[a][b][m][n] = (f32x4){0.f, 0.f, 0.f, 0.f};
    bf16x8 At[4][2], B0[2][2], B1[2][2];
    const char* cA = PG8_APTR(cur); const char* cB = (const char*)g.Bt + (size_t)cur.pn * tstepB;
    S.a_ready(cur);
    if constexpr (Epi::PREFETCH) E.prefetch(cur, 0, wid, lane);
    if constexpr (SP2) {
        PG8_STAGE(PG8_SB(0, 0), cB, voffB); PG8_STAGE(PG8_SB(0, 1), cB + hstepB, voffB); PG8_STAGE(PG8_SA(0, 0), cA, voffA); PG8_STAGE(PG8_SA(0, 1), cA + hstepA, voffA);
        if (wr == 1) PG8_BAR;
        PG8_WAIT_V(2); PG8_BAR;
        PG8_STAGE(PG8_SB(1, 0), cB + kstep, voffB); PG8_STAGE(PG8_SA(1, 0), cA + kstep, voffA); PG8_STAGE(PG8_SB(1, 1), cB + hstepB + kstep, voffB);
        PG8_WAIT_V(6); PG8_BAR;
    } else {
        PG8_STAGE(PG8_SB(0, 0), cB, voffB); PG8_STAGE(PG8_SA(0, 0), cA, voffA); PG8_STAGE(PG8_SB(0, 1), cB + hstepB, voffB); PG8_STAGE(PG8_SA(0, 1), cA + hstepA, voffA);
        if (wr == 1) PG8_BAR;
        PG8_WAIT_V(4); PG8_BAR;
        PG8_STAGE(PG8_SB(1, 0), cB + kstep, voffB); PG8_STAGE(PG8_SA(1, 0), cA + kstep, voffA); PG8_STAGE(PG8_SB(1, 1), cB + hstepB + kstep, voffB);
        PG8_WAIT_V(6); PG8_BAR;
    }
    for (;;) {
        const bool has_next = S.next(ui + 1, nxt);
        const char* nA = has_next ? PG8_APTR(nxt) : cA; const char* nB = has_next ? (const char*)g.Bt + (size_t)nxt.pn * tstepB : cB;
        for (int t = 0; t < nt; t += 2) {
            const bool last = (t == nt - 2);
            const char* a1 = cA + (size_t)(t + 1) * kstep;
            const char* a2 = last ? nA : cA + (size_t)(t + 2) * kstep; const char* b2 = last ? nB : cB + (size_t)(t + 2) * kstep;
            const char* a3 = a2 + kstep; const char* b3 = b2 + kstep;
            if (last && has_next) S.a_ready(nxt);
            if constexpr (SP2) {
            PG8_LDB(B0, 0, 0); PG8_LDB(B1, 0, 1); PG8_SCHED; PG8_LDA(At, 0, 0); PG8_STAGE(PG8_SA(1, 1), a1 + hstepA, voffA);
            PG8_WAIT_V(8); PG8_WAIT_L(0); PG8_BAR; PG8_MMA(0, 0, At, B0); PG8_MMA(0, 1, At, B1); PG8_BAR; PG8_SCHED;
            PG8_LDA(At, 0, 1); PG8_STAGE(PG8_SB(0, 0), b2, voffB); PG8_STAGE(PG8_SB(0, 1), b2 + hstepB, voffB); PG8_STAGE(PG8_SA(0, 0), a2, voffA);
            PG8_WAIT_V(8); PG8_WAIT_L(0); PG8_BAR; PG8_MMA(1, 0, At, B0); PG8_MMA(1, 1, At, B1); PG8_BAR; PG8_SCHED;
            PG8_LDB(B0, 1, 0); PG8_LDB(B1, 1, 1); PG8_SCHED; PG8_LDA(At, 1, 0); PG8_STAGE(PG8_SA(0, 1), a2 + hstepA, voffA);
            PG8_WAIT_V(8); PG8_WAIT_L(0); PG8_BAR; PG8_MMA(0, 0, At, B0); PG8_MMA(0, 1, At, B1); PG8_BAR; PG8_SCHED;
            PG8_LDA(At, 1, 1); PG8_STAGE(PG8_SB(1, 0), b3, voffB); PG8_STAGE(PG8_SB(1, 1), b3 + hstepB, voffB); PG8_STAGE(PG8_SA(1, 0), a3, voffA);
            PG8_WAIT_V(8); PG8_WAIT_L(0); PG8_BAR; PG8_MMA(1, 0, At, B0); PG8_MMA(1, 1, At, B1); PG8_BAR; PG8_SCHED;
            } else {
            PG8_LDB(B0, 0, 0); PG8_SCHED; PG8_LDA(At, 0, 0); PG8_STAGE(PG8_SA(1, 1), a1 + hstepA, voffA);
            PG8_WAIT_L(8); PG8_BAR; PG8_WAIT_L(0); PG8_MMA(0, 0, At, B0); PG8_BAR; PG8_SCHED;
            PG8_LDB(B1, 0, 1); PG8_STAGE(PG8_SB(0, 0), b2, voffB);
            PG8_BAR; PG8_WAIT_L(0); PG8_MMA(0, 1, At, B1); PG8_BAR;
            PG8_LDA(At, 0, 1); PG8_STAGE(PG8_SA(0, 0), a2, voffA);
            PG8_BAR; PG8_WAIT_L(0); PG8_MMA(1, 0, At, B0); PG8_BAR; PG8_SCHED;
            PG8_STAGE(PG8_SB(0, 1), b2 + hstepB, voffB);
            PG8_WAIT_V(6); PG8_BAR; PG8_MMA(1, 1, At, B1); PG8_BAR;
            PG8_LDB(B0, 1, 0); PG8_SCHED; PG8_LDA(At, 1, 0); PG8_STAGE(PG8_SA(0, 1), a2 + hstepA, voffA);
            PG8_WAIT_L(8); PG8_BAR; PG8_WAIT_L(0); PG8_MMA(0, 0, At, B0); PG8_BAR; PG8_SCHED;
            PG8_LDB(B1, 1, 1); PG8_STAGE(PG8_SB(1, 0), b3, voffB);
            PG8_BAR; PG8_WAIT_L(0); PG8_MMA(0, 1, At, B1); PG8_BAR;
            PG8_LDA(At, 1, 1); PG8_STAGE(PG8_SA(1, 0), a3, voffA);
            PG8_BAR; PG8_WAIT_L(0); PG8_MMA(1, 0, At, B0); PG8_BAR; PG8_SCHED;
            PG8_STAGE(PG8_SB(1, 1), b3 + hstepB, voffB);
            PG8_WAIT_V(6); PG8_BAR; PG8_MMA(1, 1, At, B1); PG8_BAR;
            }
        }
        if constexpr (ALIGN_EPI) { if (wr == 0) PG8_BAR; }
        if constexpr (!Epi::AFTER_DRAIN) { if constexpr (Epi::PREFETCH) E.run(acc, cur, wr, wc, fr, fq, ui & 1); else E(acc, cur, wr, wc, fr, fq); S.done(cur); }
        if (!has_next) break;
#pragma unroll
        for (int a = 0; a < 2; ++a)
#pragma unroll
            for (int b = 0; b < 2; ++b)
#pragma unroll
                for (int m = 0; m < 4; ++m)
#pragma unroll
                    for (int n = 0; n < 2; ++n) acc[a][b][m][n] = (f32x4){0.f, 0.f, 0.f, 0.f};
        cur = nxt; cA = nA; cB = nB; ++ui;
        if constexpr (Epi::PREFETCH) E.prefetch(cur, ui & 1, wid, lane);
        if constexpr (ALIGN_EPI) { if (wr == 1) PG8_BAR; }
    }
    PG8_WAIT_V(0);
    if constexpr (!ALIGN_EPI) { if (wr == 0) PG8_BAR; }
    PG8_BAR;
    if constexpr (Epi::AFTER_DRAIN) { E.fused(acc, cur, wr, wc, fr, fq, lds, wid, lane); S.done(cur); }
#undef PG8_APTR
#undef PG8_SA
#undef PG8_SB
#undef PG8_STAGE
#undef PG8_LDA
#undef PG8_LDB
#undef PG8_MMA
#undef PG8_WAIT_V
#undef PG8_WAIT_L
#undef PG8_BAR
#undef PG8_SCHED
}
}

#define LAS __attribute__((address_space(3)))
typedef unsigned short bf16;
typedef float f32x4 __attribute__((ext_vector_type(4)));
typedef float f32x16 __attribute__((ext_vector_type(16)));
typedef short bf16x8 __attribute__((ext_vector_type(8)));
typedef short s16x4 __attribute__((ext_vector_type(4)));
typedef unsigned u32x4 __attribute__((ext_vector_type(4)));
typedef unsigned u32x2 __attribute__((ext_vector_type(2)));

constexpr int NB = 16, SEQ = 2048, DM = 1024, NMETA = 16, LL = NMETA + SEQ  , RR = NB * LL  ;
constexpr int NHD = 16, QLR = 384, KVLR = 256, DFF = 2816, DEPTH = 4;
constexpr int NDQKV = 768;
constexpr float NORM_EPS = 1e-6f;
constexpr int UP_TILES_M = 131, UP_RSTEP = 254;
static_assert(RR % 256 == 0 && (UP_TILES_M * UP_RSTEP) >= RR, "tiling");

constexpr size_t MiB = 1u << 20;
constexpr size_t WS_ROPE = 1 * MiB;
constexpr size_t WS_MXT = 2 * MiB;
constexpr size_t SZ_UP = 5632ull * 1024 * 2, SZ_DOWN = 1024ull * 2816 * 2, SZ_DQKV = 768ull * 1024 * 2, SZ_UQ = 1536ull * 384 * 2, SZ_UKV = 2048ull * 256 * 2, SZ_O = 1024ull * 1024 * 2, SZ_POOL = 1024ull * 256 * 2;
constexpr size_t W_UP = 4 * MiB, W_DOWN = W_UP + 4 * SZ_UP, W_DQKV = W_DOWN + 4 * SZ_DOWN, W_UQ = W_DQKV + 2 * SZ_DQKV, W_UKV = W_UQ + 2 * SZ_UQ, W_O = W_UKV + 2 * SZ_UKV, W_POOL = W_O + 2 * SZ_O, W_END = W_POOL + 2 * SZ_POOL;
constexpr size_t WS_X0 = (W_END + MiB - 1) / MiB * MiB;
constexpr size_t WS_T1 = WS_X0, WS_CQ = WS_T1 + (size_t)RR * 768 * 2, WS_CKV = WS_CQ + (size_t)RR * 384 * 2, WS_KR = WS_CKV + (size_t)RR * 256 * 2;
constexpr size_t WS_Q = WS_KR + (size_t)RR * 32 * 2, WS_KV = WS_Q + (size_t)RR * 1536 * 2, WS_APAD = WS_KV + (size_t)RR * 2048 * 2;
constexpr size_t WS_H16 = WS_APAD, WS_END = WS_H16 + (size_t)(RR + 512) * 1024 * 2;
constexpr size_t WS_PS = WS_X0 + (size_t)RR * 768 * 2 + (size_t)RR * 384 * 2;
constexpr size_t WS_RSQ = 1 * MiB + 672 * 1024, WS_RSK = 1 * MiB + 832 * 1024;
constexpr size_t WS_RSTD = 1 * MiB + 512 * 1024;
constexpr size_t WS_O = WS_T1;
constexpr size_t WS_MX = WS_KV;
constexpr size_t WS_G = WS_X0;
constexpr size_t WS_MIX = WS_X0;
static_assert(WS_O + (size_t)RR * 1024 * 2 <= WS_CKV, "O overlays T1|CQ only");
static_assert(WS_G + (size_t)RR * 2816 * 2 <= WS_KV, "G overlays T1..Q only");

constexpr int LDS_BYTES = 155648;
constexpr int XCH_OFF = 131072 + 1024;

struct Params { const float* in[18]; float* out; unsigned char* ws; float inv_freq[16]; };
typedef const __attribute__((address_space(4))) Params* KP;
__device__ __forceinline__ KP kp_fresh(KP k) { asm volatile("" : "+s"(k)); return k; }
__device__ __forceinline__ int lane_id() { int l; asm volatile("v_mbcnt_lo_u32_b32 %0, -1, 0\n\tv_mbcnt_hi_u32_b32 %0, -1, %0" : "=v"(l)); return l; }
__device__ __forceinline__ float lane_xchg(float v, int srclane) { return __builtin_bit_cast(float, __builtin_amdgcn_ds_bpermute(srclane << 2, __builtin_bit_cast(int, v))); }
__device__ __forceinline__ int tid_fresh(int wid) { return wid * 64 + lane_id(); }

__device__ __forceinline__ unsigned f2bf(float f) { unsigned u = __builtin_bit_cast(unsigned, f); return (u + 0x7fffu + ((u >> 16) & 1u)) >> 16; }
typedef float pk_f32x2 __attribute__((ext_vector_type(2))); typedef __bf16 pk_bf16x2 __attribute__((ext_vector_type(2)));
__device__ __forceinline__ unsigned pk2(float lo, float hi) { const pk_f32x2 v = {lo, hi}; const pk_bf16x2 b = __builtin_convertvector(v, pk_bf16x2); return __builtin_bit_cast(unsigned, b); }
__device__ __forceinline__ float bflo(unsigned w) { return __builtin_bit_cast(float, w << 16); }
__device__ __forceinline__ float bfhi(unsigned w) { return __builtin_bit_cast(float, w & 0xffff0000u); }
__device__ __forceinline__ float lane_xchg_(float v, int srclane) { return __builtin_bit_cast(float, __builtin_amdgcn_ds_bpermute(srclane << 2, __builtin_bit_cast(int, v))); }
__device__ __forceinline__ float wave_sum(float v, int lane) {
#pragma unroll
    for (int o = 32; o > 0; o >>= 1) v += lane_xchg_(v, lane ^ o);
    return v;
}
#define XB_TMO      128
#define XB_XCNT(j)  (256  + 64 * (j))
#define XB_XSUB(j)  (1280 + 64 * (j))
#define XB_XGEN(j)  (2304 + 64 * (j))
#define XB_TOP      3328
#define XB_TOPGEN   3392
#define XCD_BAR_WORDS 3456
#define XB_SPIN_CAP (1u << 18)

__device__ __forceinline__ unsigned xb_ld(unsigned* p)              { return __hip_atomic_load(p, __ATOMIC_RELAXED, __HIP_MEMORY_SCOPE_AGENT); }
__device__ __forceinline__ unsigned xb_add(unsigned* p, unsigned v) { return __hip_atomic_fetch_add(p, v, __ATOMIC_RELAXED, __HIP_MEMORY_SCOPE_AGENT); }
__device__ __forceinline__ unsigned xb_xcc_id() { return (unsigned)__builtin_amdgcn_s_getreg((3 << 11) | 20) & 0xFu; }
#define XB_SPIN(cond, bar) do { unsigned _sp = 0; while (cond) { __builtin_amdgcn_s_sleep(1); \
    if ((++_sp & 255u) == 0u) { if (xb_ld(&(bar)[XB_TMO])) break; if (_sp > XB_SPIN_CAP) { atomicAdd(&(bar)[XB_TMO], 1u); break; } } } } while (0)

struct XcdBarrier {
    unsigned* bar; unsigned x;
    volatile LAS unsigned* st;
};

__device__ __forceinline__ XcdBarrier xcd_barrier_post(unsigned* bar, volatile LAS unsigned* st, int tid) {
    XcdBarrier b; b.bar = bar; b.x = xb_xcc_id(); b.st = st;
    if (tid == 0) (void)xb_add(&bar[XB_XCNT(b.x)], 1u);
    return b;
}
__device__ __forceinline__ void xcd_barrier_complete(unsigned* bar, unsigned x, unsigned& nloc, unsigned& nx) {
    const unsigned G = gridDim.x * gridDim.y * gridDim.z;
    unsigned sum, cnt, mine, sp = 0u;
    for (;;) {
        sum = 0u; cnt = 0u; mine = 0u;
#pragma unroll
        for (unsigned j = 0; j < 16; ++j) { const unsigned c = xb_ld(&bar[XB_XCNT(j)]); sum += c; cnt += (c > 0u) ? 1u : 0u; mine = (j == x) ? c : mine; }
        if (sum == G) break;
        __builtin_amdgcn_s_sleep(1);
        if ((++sp & 255u) == 0u) { if (xb_ld(&bar[XB_TMO])) break; if (sp > XB_SPIN_CAP) { atomicAdd(&bar[XB_TMO], 1u); break; } }
    }
    nloc = mine > 0u ? mine : 1u; nx = cnt > 0u ? cnt : 1u;
}

__device__ __forceinline__ void xcd_barrier(const XcdBarrier& b, int tid) {
    asm volatile("s_waitcnt vmcnt(0)" ::: "memory");
    __syncthreads();
    if (tid == 0) {
        unsigned* bar = b.bar;
        __builtin_amdgcn_s_waitcnt(0);
        unsigned nloc = b.st[0], nx = b.st[1];
        if (nloc == 0u) { xcd_barrier_complete(bar, b.x, nloc, nx); b.st[0] = nloc; b.st[1] = nx; }
        const unsigned old = xb_add(&bar[XB_XSUB(b.x)], 1u);
        const unsigned gen = old / nloc;
        if (old + 1u == (gen + 1u) * nloc) {
            __builtin_amdgcn_fence(__ATOMIC_RELEASE, "agent");
            asm volatile("s_waitcnt vmcnt(0)" ::: "memory");
            const unsigned og = xb_add(&bar[XB_TOP], 1u);
            const unsigned tg = og / nx;
            if (og + 1u == (tg + 1u) * nx) xb_add(&bar[XB_TOPGEN], 1u);
            else XB_SPIN(xb_ld(&bar[XB_TOPGEN]) == tg, bar);
            __builtin_amdgcn_fence(__ATOMIC_ACQUIRE, "agent");
            xb_add(&bar[XB_XGEN(b.x)], 1u);
            asm volatile("s_waitcnt vmcnt(0)" ::: "memory");
        } else {
            XB_SPIN(xb_ld(&bar[XB_XGEN(b.x)]) == gen, bar);
            __builtin_amdgcn_fence(__ATOMIC_ACQUIRE, "agent");
            asm volatile("s_waitcnt vmcnt(0)" ::: "memory");
        }
    }
    __syncthreads();
}

constexpr int XBST_OFF = 155392;
__device__ __forceinline__ void gsync(KP kp, LAS unsigned char* lds, int wid0) {
    kp = kp_fresh(kp);
    XcdBarrier b; b.bar = (unsigned*)kp->ws; b.x = xb_xcc_id(); b.st = (volatile LAS unsigned*)(lds + XBST_OFF);
    xcd_barrier(b, tid_fresh(wid0));
}
__device__ __forceinline__ void tail_barrier(unsigned* ctr, int tid, unsigned nwg) {
    asm volatile("s_waitcnt vmcnt(0)" ::: "memory");
    __syncthreads();
    if (tid == 0) {
        __builtin_amdgcn_fence(__ATOMIC_RELEASE, "agent");
        asm volatile("s_waitcnt vmcnt(0)" ::: "memory");
        (void)xb_add(ctr, 1u);
        unsigned sp = 0u;
        while (xb_ld(ctr) < nwg) { __builtin_amdgcn_s_sleep(1); if (++sp > (1u << 22)) break; }
        __builtin_amdgcn_fence(__ATOMIC_ACQUIRE, "agent");
        asm volatile("s_waitcnt vmcnt(0)" ::: "memory");
    }
    __syncthreads();
}
__device__ __forceinline__ bf16* hrow16(unsigned char* ws, int r) { return (bf16*)(ws + WS_H16) + ((size_t)r << 10); }
__device__ __forceinline__ void unpack8(const u32x4 w, float* v) { v[0] = bflo(w.x); v[1] = bfhi(w.x); v[2] = bflo(w.y); v[3] = bfhi(w.y); v[4] = bflo(w.z); v[5] = bfhi(w.z); v[6] = bflo(w.w); v[7] = bfhi(w.w); }

struct WTile { const float* src; bf16* dst; const float* scale; const float* kscale; int K, Nsrc, map, k0, n0; };
__device__ __forceinline__ WTile wtile_decode(KP kp, int ti) {
    constexpr int T_UP = 1408, T_DOWN = 704, T_DQKV = 192, T_UQ = 144, T_UKV = 128, T_O = 256, T_PG = 16;
    constexpr int B1 = 4 * T_UP, B2 = B1 + 4 * T_DOWN, B3 = B2 + 2 * T_DQKV, B4 = B3 + 2 * T_UQ, B5 = B4 + 2 * T_UKV, B6 = B5 + 2 * T_O;
    unsigned char* ws = kp->ws; WTile w; w.scale = nullptr; w.kscale = nullptr; w.map = 0; int nkt, loc;
    if (ti < B1)      { const int l = ti / T_UP; loc = ti % T_UP; w.src = kp->in[14] + (size_t)l * 1024 * 5632; w.dst = (bf16*)(ws + W_UP + l * SZ_UP); w.K = 1024; w.Nsrc = 5632; nkt = 16; w.map = 2; w.kscale = kp->in[4] + l * 1024; }
    else if (ti < B2) { const int q = ti - B1, l = q / T_DOWN; loc = q % T_DOWN; w.src = kp->in[17] + (size_t)l * 2816 * 1024; w.dst = (bf16*)(ws + W_DOWN + l * SZ_DOWN); w.K = 2816; w.Nsrc = 1024; nkt = 44; }
    else if (ti < B3) { const int q = ti - B2, l = q / T_DQKV; loc = q % T_DQKV; w.src = kp->in[6] + (size_t)l * 1024 * 672; w.dst = (bf16*)(ws + W_DQKV + l * SZ_DQKV); w.K = 1024; w.Nsrc = 672; nkt = 16; w.kscale = kp->in[2] + (2 * l) * 1024; }
    else if (ti < B4) { const int q = ti - B3, l = q / T_UQ; loc = q % T_UQ; w.src = kp->in[8] + (size_t)l * 384 * 1536; w.dst = (bf16*)(ws + W_UQ + l * SZ_UQ); w.K = 384; w.Nsrc = 1536; nkt = 6; w.map = 1; w.kscale = kp->in[7] + l * 384; }
    else if (ti < B5) { const int q = ti - B4, l = q / T_UKV; loc = q % T_UKV; w.src = kp->in[10] + (size_t)l * 256 * 2048; w.dst = (bf16*)(ws + W_UKV + l * SZ_UKV); w.K = 256; w.Nsrc = 2048; nkt = 4; w.kscale = kp->in[9] + l * 256; }
    else if (ti < B6) { const int q = ti - B5, l = q / T_O; loc = q % T_O; w.src = kp->in[11] + (size_t)l * 1024 * 1024; w.dst = (bf16*)(ws + W_O + l * SZ_O); w.K = 1024; w.Nsrc = 1024; nkt = 16; }
    else              { const int q = ti - B6, lg = q / T_PG; loc = q % T_PG; w.src = kp->in[12] + (size_t)lg * 256 * 256; w.dst = (bf16*)(ws + W_POOL) + (size_t)lg * 256 * 256; w.K = 256; w.Nsrc = 256; nkt = 4; w.scale = kp->in[13] + lg * 256; w.kscale = kp->in[2] + (2 * (lg >> 2) + 1) * 1024 + (lg & 3) * 256; }
    { const int ntiles_n = (ti < B1 ? T_UP : ti < B2 ? T_DOWN : ti < B3 ? T_DQKV : ti < B4 ? T_UQ : ti < B5 ? T_UKV : ti < B6 ? T_O : T_PG) / nkt;
      w.n0 = (loc % ntiles_n) * 64; w.k0 = (loc / ntiles_n) * 64; }
    return w;
}
__device__ __forceinline__ void wtile_load(const WTile& w, int tid, float (&v)[8]) {
    const int n = w.n0 + (tid & 63);
    int sc;
    if (w.map == 1) sc = n < 1024 ? (n >> 6) * 96 + (n & 63) : ((n - 1024) >> 5) * 96 + 64 + ((n - 1024) & 31);
    else if (w.map == 2) sc = ((n >> 7) & 1) * 2816 + (n >> 8) * 128 + (n & 127);
    else sc = n < w.Nsrc ? n : -1;
    const float s = w.scale ? w.scale[n] : 1.0f;
#pragma unroll
    for (int i = 0; i < 8; ++i) { const int k = i * 8 + (tid >> 6); v[i] = sc >= 0 ? __builtin_nontemporal_load(w.src + (size_t)(w.k0 + k) * w.Nsrc + sc) * s * (w.kscale ? w.kscale[w.k0 + k] : 1.0f) : 0.f; }
}
constexpr int W_TILES = 4 * 1408 + 4 * 704 + 2 * 192 + 2 * 144 + 2 * 128 + 2 * 256 + 8 * 16;
__device__ __forceinline__ void prologue_weights(KP kp, LAS float* tile, int wid0) {
    kp = kp_fresh(kp);
    const int tid = tid_fresh(wid0);
    int ti = blockIdx.x;
    if (ti >= W_TILES) return;
    WTile w = wtile_decode(kp, ti);
    float v[8];
    wtile_load(w, tid, v);
    int par = 0;
    for (;;) {
        LAS float* tb = tile + par * (64 * 65);
#pragma unroll
        for (int i = 0; i < 8; ++i) tb[(i * 8 + (tid >> 6)) * 65 + (tid & 63)] = v[i];
        __syncthreads();
        const int tn = ti + (int)gridDim.x; const bool more = tn < W_TILES;
        WTile wn = w;
        if (more) { wn = wtile_decode(kp, tn); wtile_load(wn, tid, v); }
        {
            const int nl = tid >> 3, kc = tid & 7;
            float o[8];
#pragma unroll
            for (int j = 0; j < 8; ++j) o[j] = tb[(kc * 8 + j) * 65 + nl];
            u32x4 pk; pk.x = pk2(o[0], o[1]); pk.y = pk2(o[2], o[3]); pk.z = pk2(o[4], o[5]); pk.w = pk2(o[6], o[7]);
            *(u32x4*)(w.dst + (size_t)(w.n0 + nl) * w.K + w.k0 + kc * 8) = pk;
        }
        if (!more) break;
        w = wn; ti = tn; par ^= 1;
    }
    __syncthreads();
}

__device__ __forceinline__ void prologue_rope(KP kp, int wid0) {
    kp = kp_fresh(kp); const int tid = tid_fresh(wid0);
    float* rc = (float*)(kp->ws + WS_ROPE); float* rs = rc + LL * 16;
    for (int i = blockIdx.x * 512 + tid; i < LL * 16; i += gridDim.x * 512) {
        const int t = i >> 4, e = i & 15;
        const float ang = (float)t * kp->inv_freq[e];
        const double rev = (double)ang * 0.15915494309189535;
        const float fr = (float)(rev - __builtin_rint(rev));
        rc[i] = __builtin_amdgcn_cosf(fr); rs[i] = __builtin_amdgcn_sinf(fr);
    }
}

__device__ __forceinline__ void row_init(KP kp, int wid0) {
    kp = kp_fresh(kp); const int tid = tid_fresh(wid0); const int lane = tid & 63, wid = tid >> 6;
    unsigned char* ws = kp->ws; const float* xin = kp->in[0]; const float* meta = kp->in[1]; float* rsd = (float*)(ws + WS_RSTD);
    for (int row = blockIdx.x * 8 + wid; row < RR; row += gridDim.x * 8) {
        const int b = row / LL, t = row - b * LL;
        const float* src = t < NMETA ? meta + (size_t)t * DM : xin + ((size_t)b * SEQ + (t - NMETA)) * DM;
        bf16* hp = hrow16(ws, row);
        float ss = 0.f;
#pragma unroll
        for (int c = 0; c < 2; ++c) { const f32x4 v0 = __builtin_nontemporal_load((const f32x4*)(src + c * 512 + lane * 8)), v1 = __builtin_nontemporal_load((const f32x4*)(src + c * 512 + lane * 8 + 4));
            ss += v0[0] * v0[0] + v0[1] * v0[1] + v0[2] * v0[2] + v0[3] * v0[3] + v1[0] * v1[0] + v1[1] * v1[1] + v1[2] * v1[2] + v1[3] * v1[3];
            u32x4 hw; hw.x = pk2(v0[0], v0[1]); hw.y = pk2(v0[2], v0[3]); hw.z = pk2(v1[0], v1[1]); hw.w = pk2(v1[2], v1[3]);
            *(u32x4*)(hp + c * 512 + lane * 8) = hw; }
        ss = wave_sum(ss, lane);
        if (lane == 0) rsd[row] = 1.0f / sqrtf(ss * (1.0f / DM) + NORM_EPS);
    }
}

__device__ __forceinline__ void row_res(KP kp, int gpost_in, int layer, bool has_next, int wid0, int row0, int row1, int b0, int nb, int tailp, bool pooled) {
    kp = kp_fresh(kp); const int tid = tid_fresh(wid0); const int lane = tid & 63, wid = tid >> 6;
    unsigned char* ws = kp->ws; float* out = kp->out; const bf16* MX = (const bf16*)(ws + WS_MX); float* rsd = (float*)(ws + WS_RSTD);
    const float* g_post = kp->in[gpost_in] + layer * DM;
    for (int base = row0 + ((int)blockIdx.x - b0) * 16 + wid; base < row1; base += nb * 16) {
        float m[2][2][8], h[2][2][8]; float ss[2] = {0.f, 0.f};
#pragma unroll
        for (int r = 0; r < 2; ++r) { const int row = base + 8 * r; bf16* hp = hrow16(ws, row);
#pragma unroll
            for (int c = 0; c < 2; ++c) {
                if (tailp) { const bf16* t0 = (const bf16*)(ws + WS_MXT) + (size_t)(row - 128 * 256) * DM + c * 512 + lane * 8; unpack8(*(const u32x4*)t0, m[r][c]);
                    for (int q = 1; q < tailp; ++q) { float m2[8]; unpack8(*(const u32x4*)(t0 + (size_t)q * 256 * 1024), m2);
#pragma unroll
                        for (int j = 0; j < 8; ++j) m[r][c][j] += m2[j]; } }
                else if (pooled) { const int t = row % LL, win = 2 << (c * 2 + (lane >> 5)), cnt = (t + 1) < win ? (t + 1) : win; const bf16* zp = MX + (size_t)row * DM + c * 512 + lane * 8;
                    float z0[8], sum[8]; unpack8(*(const u32x4*)zp, z0);
#pragma unroll
                    for (int j = 0; j < 8; ++j) sum[j] = z0[j];
                    for (int d = 1; d < cnt; ++d) { float zd[8]; unpack8(*(const u32x4*)(zp - (size_t)d * DM), zd);
#pragma unroll
                        for (int j = 0; j < 8; ++j) sum[j] += zd[j]; }
                    const float inv = 1.0f / (float)cnt;
#pragma unroll
                    for (int j = 0; j < 8; ++j) m[r][c][j] = sum[j] * inv - z0[j]; }
                else { const u32x4 w = __builtin_nontemporal_load((const u32x4*)(MX + (size_t)row * DM + c * 512 + lane * 8)); unpack8(w, m[r][c]); }
                unpack8(*(const u32x4*)(hp + c * 512 + lane * 8), h[r][c]);
#pragma unroll
                for (int j = 0; j < 8; ++j) ss[r] += m[r][c][j] * m[r][c][j]; } }
#pragma unroll
        for (int o = 32; o > 0; o >>= 1) { const float a = lane_xchg_(ss[0], lane ^ o), b = lane_xchg_(ss[1], lane ^ o); ss[0] += a; ss[1] += b; }
        float s2[2] = {0.f, 0.f};
#pragma unroll
        for (int r = 0; r < 2; ++r) { const float rstd = 1.0f / sqrtf(ss[r] * (1.0f / DM) + NORM_EPS);
#pragma unroll
            for (int c = 0; c < 2; ++c) { const int col = c * 512 + lane * 8; const f32x4 ga = *(const f32x4*)(g_post + col), gb = *(const f32x4*)(g_post + col + 4);
#pragma unroll
                for (int j = 0; j < 8; ++j) { h[r][c][j] += m[r][c][j] * rstd * (j < 4 ? ga[j & 3] : gb[j & 3]); s2[r] += h[r][c][j] * h[r][c][j]; } } }
        if (has_next) {
#pragma unroll
            for (int o = 32; o > 0; o >>= 1) { const float a = lane_xchg_(s2[0], lane ^ o), b = lane_xchg_(s2[1], lane ^ o); s2[0] += a; s2[1] += b; }
#pragma unroll
            for (int r = 0; r < 2; ++r) { const int row = base + 8 * r; bf16* hp = hrow16(ws, row);
#pragma unroll
                for (int c = 0; c < 2; ++c) { u32x4 hw; hw.x = pk2(h[r][c][0], h[r][c][1]); hw.y = pk2(h[r][c][2], h[r][c][3]); hw.z = pk2(h[r][c][4], h[r][c][5]); hw.w = pk2(h[r][c][6], h[r][c][7]);
                    *(u32x4*)(hp + c * 512 + lane * 8) = hw; }
                if (lane == 0) rsd[row] = 1.0f / sqrtf(s2[r] * (1.0f / DM) + NORM_EPS); }
        } else {
#pragma unroll
            for (int r = 0; r < 2; ++r) { const int row = base + 8 * r; const int b = row / LL, t = row - b * LL;
                if (t >= NMETA) { float* op = out + (((size_t)b * SEQ + (t - NMETA)) << 10);
#pragma unroll
                    for (int c = 0; c < 2; ++c) { const int col = c * 512 + lane * 8;
                        __builtin_nontemporal_store((f32x4){h[r][c][0], h[r][c][1], h[r][c][2], h[r][c][3]}, (f32x4*)(op + col)); __builtin_nontemporal_store((f32x4){h[r][c][4], h[r][c][5], h[r][c][6], h[r][c][7]}, (f32x4*)(op + col + 4)); } } }
        }
    }
}

__device__ __forceinline__ void row_latent(KP kp, int jl, int wid0) {
    kp = kp_fresh(kp); const int tid = tid_fresh(wid0); const int lane = tid & 63, wid = tid >> 6;
    unsigned char* ws = kp->ws; const bf16* T1 = (const bf16*)(ws + WS_T1); bf16* KR = (bf16*)(ws + WS_KR); float* rsq = (float*)(ws + WS_RSQ); float* rsk = (float*)(ws + WS_RSK);
    const float* rc = (const float*)(ws + WS_ROPE); const float* rs = rc + LL * 16;
    (void)jl;
    for (int row = blockIdx.x * 8 + wid; row < RR; row += gridDim.x * 8) {
        const bf16* tp = T1 + (size_t)row * NDQKV;
        float sq = 0.f, sk = 0.f;
#pragma unroll
        for (int i = 0; i < 3; ++i) { const unsigned w = *(const unsigned*)(tp + i * 128 + lane * 2); const float a = bflo(w), b = bfhi(w); sq += a * a + b * b; }
#pragma unroll
        for (int i = 0; i < 2; ++i) { const unsigned w = *(const unsigned*)(tp + 384 + i * 128 + lane * 2); const float a = bflo(w), b = bfhi(w); sk += a * a + b * b; }
        sq = wave_sum(sq, lane); sk = wave_sum(sk, lane);
        if (lane == 0) { rsq[row] = 1.0f / sqrtf(sq * (1.0f / QLR) + NORM_EPS); rsk[row] = 1.0f / sqrtf(sk * (1.0f / KVLR) + NORM_EPS); }
        if (lane < 16) {
            const int t = row % LL;
            const float x1 = __builtin_bit_cast(float, (unsigned)tp[640 + lane] << 16), x2 = __builtin_bit_cast(float, (unsigned)tp[656 + lane] << 16);
            const float c = rc[t * 16 + lane], s = rs[t * 16 + lane];
            KR[(size_t)row * 32 + lane] = (bf16)f2bf(x1 * c - x2 * s); KR[(size_t)row * 32 + 16 + lane] = (bf16)f2bf(x2 * c + x1 * s);
        }
    }
}

namespace att {
constexpr int KPT = 208, VP = 136, KBYTES = 64 * KPT, VBYTES = 64 * VP;
constexpr int VOFF = 2 * KBYTES;
typedef float f32x2 __attribute__((ext_vector_type(2))); typedef __bf16 bf16x2_t __attribute__((ext_vector_type(2)));
__device__ __forceinline__ unsigned cvtpk(float lo, float hi) { const f32x2 v = {lo, hi}; const bf16x2_t b = __builtin_convertvector(v, bf16x2_t); return __builtin_bit_cast(unsigned, b); }

__device__ __forceinline__ void qk_tile(f32x16& s0, f32x16& s1, LAS unsigned char* kb, const bf16x8 (&qr)[6], const f32x16& negm, int r32, int hi) {
    bf16x8 kf[12];
#pragma unroll
    for (int ks = 0; ks < 6; ++ks) { kf[2 * ks] = *(const LAS bf16x8*)(kb + r32 * KPT + ks * 32 + hi * 16); kf[2 * ks + 1] = *(const LAS bf16x8*)(kb + (32 + r32) * KPT + ks * 32 + hi * 16); }
    __builtin_amdgcn_sched_barrier(0);
#pragma unroll
    for (int ks = 0; ks < 6; ++ks) {
        s0 = __builtin_amdgcn_mfma_f32_32x32x16_bf16(kf[2 * ks], qr[ks], ks == 0 ? negm : s0, 0, 0, 0);
        s1 = __builtin_amdgcn_mfma_f32_32x32x16_bf16(kf[2 * ks + 1], qr[ks], ks == 0 ? negm : s1, 0, 0, 0);
    }
}
__device__ __forceinline__ void sm_pv(f32x16& s0, f32x16& s1, f32x16& o0, f32x16& o1, float& m_run, float& l_run, f32x16& negm, LAS unsigned char* vb, bool domask, int kbase, int qm, int r32, int hi) {
    s16x4 vlo[8], vhh[8];
#pragma unroll
    for (int kk = 0; kk < 4; ++kk) { const int koff = 2 * (16 * kk + 4 * hi);
        vlo[2 * kk] = *(const LAS s16x4*)(vb + r32 * VP + koff); vhh[2 * kk] = *(const LAS s16x4*)(vb + r32 * VP + koff + 16);
        vlo[2 * kk + 1] = *(const LAS s16x4*)(vb + (32 + r32) * VP + koff); vhh[2 * kk + 1] = *(const LAS s16x4*)(vb + (32 + r32) * VP + koff + 16); }
    __builtin_amdgcn_sched_barrier(0);
    if (domask) {
        const int kb0 = kbase + 4 * hi;
#pragma unroll
        for (int r = 0; r < 16; ++r) { const int kv = kb0 + (r & 3) + 8 * (r >> 2); if (kv > qm) s0[r] = -INFINITY; if (kv + 32 > qm) s1[r] = -INFINITY; }
    }
    float ma = fmaxf(fmaxf(s0[0], s0[1]), s1[0]), mb = fmaxf(fmaxf(s0[2], s0[3]), s1[1]);
    ma = fmaxf(fmaxf(ma, s1[2]), s1[3]);
#pragma unroll
    for (int r = 4; r < 16; r += 4) { ma = fmaxf(fmaxf(ma, s0[r]), s0[r + 1]); mb = fmaxf(fmaxf(mb, s0[r + 2]), s0[r + 3]); ma = fmaxf(fmaxf(ma, s1[r]), s1[r + 1]); mb = fmaxf(fmaxf(mb, s1[r + 2]), s1[r + 3]); }
    float mx = fmaxf(ma, mb);
    { const auto rr = __builtin_amdgcn_permlane32_swap(__float_as_uint(mx), __float_as_uint(mx), false, false); mx = fmaxf(__uint_as_float(rr[0]), __uint_as_float(rr[1])); }
    if (__builtin_amdgcn_ballot_w64(mx > 8.0f) != 0ull) {
        const float d = fmaxf(mx, 0.0f);
        const float alpha = __builtin_amdgcn_exp2f(-d);
        m_run += d; l_run *= alpha; o0 = o0 * alpha; o1 = o1 * alpha;
        s0 = s0 - d; s1 = s1 - d;
#pragma unroll
        for (int r = 0; r < 16; ++r) negm[r] = -m_run;
    }
    f32x2 ps2 = (f32x2){0.f, 0.f};
#pragma unroll
    for (int r = 0; r < 16; r += 2) { s0[r] = __builtin_amdgcn_exp2f(s0[r]); s0[r + 1] = __builtin_amdgcn_exp2f(s0[r + 1]); s1[r] = __builtin_amdgcn_exp2f(s1[r]); s1[r + 1] = __builtin_amdgcn_exp2f(s1[r + 1]);
        ps2 += (f32x2){s0[r], s0[r + 1]}; ps2 += (f32x2){s1[r], s1[r + 1]}; }
    l_run += ps2[0] + ps2[1];
    u32x4 pw[4];
#pragma unroll
    for (int i = 0; i < 4; ++i) { pw[0][i] = cvtpk(s0[2 * i], s0[2 * i + 1]); pw[1][i] = cvtpk(s0[8 + 2 * i], s0[8 + 2 * i + 1]); pw[2][i] = cvtpk(s1[2 * i], s1[2 * i + 1]); pw[3][i] = cvtpk(s1[8 + 2 * i], s1[8 + 2 * i + 1]); }
#pragma unroll
    for (int kk = 0; kk < 4; ++kk) {
        const bf16x8 pf = __builtin_bit_cast(bf16x8, pw[kk]);
        { const s16x4 lo = vlo[2 * kk], hh = vhh[2 * kk];
          const bf16x8 vf = (bf16x8){lo[0], lo[1], lo[2], lo[3], hh[0], hh[1], hh[2], hh[3]};
          o0 = __builtin_amdgcn_mfma_f32_32x32x16_bf16(vf, pf, o0, 0, 0, 0); }
        { const s16x4 lo = vlo[2 * kk + 1], hh = vhh[2 * kk + 1];
          const bf16x8 vf = (bf16x8){lo[0], lo[1], lo[2], lo[3], hh[0], hh[1], hh[2], hh[3]};
          o1 = __builtin_amdgcn_mfma_f32_32x32x16_bf16(vf, pf, o1, 0, 0, 0); }
    }
}

__device__ __forceinline__ void attn_phase(LAS unsigned char* lds, KP kp, int wid0) {
    kp = kp_fresh(kp); unsigned char* ws = kp->ws;
    const bf16* Q = (const bf16*)(ws + WS_Q); const bf16* KV = (const bf16*)(ws + WS_KV); const bf16* KR = (const bf16*)(ws + WS_KR); bf16* O = (bf16*)(ws + WS_O);
    const int tid = tid_fresh(wid0), lane = tid & 63, wid = tid >> 6, r32 = lane & 31, hi = lane >> 5;
    const int key_l = tid >> 3, c8 = tid & 7;
    const int kp2 = tid >> 4, g4 = tid & 15;
    (void)lane;
    for (int bh = blockIdx.x; bh < NB * NHD; bh += gridDim.x) {
        const int b = bh >> 4, h = bh & 15, rowb = b * LL;
        bf16x8 qr[6];
        u32x4 kregA, rregA = {}, kregB, rregB = {}; u32x2 vaA, vbA, vaB, vbB;
#define ATT_BAR() do { asm volatile("s_waitcnt lgkmcnt(0)" ::: "memory"); __builtin_amdgcn_s_barrier(); asm volatile("" ::: "memory"); } while (0)
#define ATT_LOADQ(qm_) do { const bf16* qp_ = Q + (size_t)(rowb + (qm_)) * 1536; \
            _Pragma("unroll") for (int ks = 0; ks < 4; ++ks) qr[ks] = __builtin_nontemporal_load((const bf16x8*)(qp_ + h * 64 + ks * 16 + hi * 8));     \
            _Pragma("unroll") for (int ks = 0; ks < 2; ++ks) qr[4 + ks] = __builtin_nontemporal_load((const bf16x8*)(qp_ + 1024 + h * 32 + ks * 16 + hi * 8)); } while (0)
#define ATT_LOADK(kt_, S_) do { int grow_ = rowb + 64 * (kt_) + key_l; grow_ = grow_ < RR ? grow_ : RR - 1; \
            kreg##S_ = *(const u32x4*)(KV + (size_t)grow_ * 2048 + h * 128 + c8 * 8); rreg##S_ = *(const u32x4*)(KR + (size_t)grow_ * 32 + (c8 & 3) * 8); } while (0)
#define ATT_LOADV(kt_, S_) do { int g0_ = rowb + 64 * (kt_) + 2 * kp2, g1_ = g0_ + 1; g0_ = g0_ < RR ? g0_ : RR - 1; g1_ = g1_ < RR ? g1_ : RR - 1; \
            va##S_ = *(const u32x2*)(KV + (size_t)g0_ * 2048 + h * 128 + 64 + g4 * 4); vb##S_ = *(const u32x2*)(KV + (size_t)g1_ * 2048 + h * 128 + 64 + g4 * 4); } while (0)
#define ATT_STOREK(slot_, S_) do { LAS unsigned char* kb_ = lds + (slot_) * KBYTES; \
            *(LAS u32x4*)(kb_ + key_l * KPT + c8 * 16) = kreg##S_; if (c8 < 4) *(LAS u32x4*)(kb_ + key_l * KPT + 128 + c8 * 16) = rreg##S_; } while (0)
#define ATT_STOREV(slot_, S_) do { LAS unsigned char* vb_ = lds + VOFF + (slot_) * VBYTES + (g4 * 4) * VP + kp2 * 4;     \
            *(LAS unsigned*)(vb_) = (va##S_.x & 0xffffu) | (vb##S_.x << 16); *(LAS unsigned*)(vb_ + VP) = (va##S_.x >> 16) | (vb##S_.x & 0xffff0000u); \
            *(LAS unsigned*)(vb_ + 2 * VP) = (va##S_.y & 0xffffu) | (vb##S_.y << 16); *(LAS unsigned*)(vb_ + 3 * VP) = (va##S_.y >> 16) | (vb##S_.y & 0xffff0000u); } while (0)
#define ATT_ITER(kt_, SA_, SB_, P_) do { const int kt = (kt_); const int tl_ = kt + 2 < NT ? kt + 2 : kt + 2 - NT; \
            ATT_LOADK(tl_, SB_); ATT_LOADV(tl_, SB_);     \
            if (64 * kt <= qwmax) { f32x16 sc0, sc1; \
                qk_tile(sc0, sc1, lds + ((kt + (P_)) & 1) * KBYTES, qr, negm, r32, hi); \
                sm_pv(sc0, sc1, o0, o1, m_run, l_run, negm, lds + VOFF + ((kt + (P_)) & 1) * VBYTES, 64 * kt + 63 > qwmin, 64 * kt, qm, r32, hi); } \
            ATT_STOREK((kt + 1 + (P_)) & 1, SA_); ATT_STOREV((kt + 1 + (P_)) & 1, SA_); \
            ATT_BAR(); } while (0)
        {
            const int qm0 = -240 + 32 * wid + r32;
            ATT_LOADQ(qm0 < 0 ? 0 : qm0);
            ATT_LOADK(0, A); ATT_LOADV(0, A);
            ATT_STOREK(0, A); ATT_STOREV(0, A);
            ATT_LOADK(0, A); ATT_LOADV(0, A);
            ATT_BAR();
        }
        for (int j = 0; j < 9; ++j) {
            const int q0 = j == 0 ? -240 : 16 + 256 * (j - 1);
            const int NT = (q0 + 256 + 63) >> 6;
            const int qw0 = q0 + 32 * wid, q = qw0 + r32, qm = q < 0 ? 0 : q;
            const int qwmax = (qw0 + 31) < 0 ? 0 : (qw0 + 31), qwmin = qw0 < 0 ? 0 : qw0;
            float m_run = 0.f, l_run = 0.f;
            f32x16 o0 = {}, o1 = {}, negm = {};
            if ((j & 1) == 0) {
                for (int kt2 = 0; kt2 < NT; kt2 += 2) { ATT_ITER(kt2, A, B, 0); if (kt2 + 1 < NT) ATT_ITER(kt2 + 1, B, A, 0); }
            } else {
                for (int kt2 = 0; kt2 < NT; kt2 += 2) { ATT_ITER(kt2, B, A, 1); if (kt2 + 1 < NT) ATT_ITER(kt2 + 1, A, B, 1); }
            }
            if (j < 8) { const int qn = 16 + 256 * j + 32 * wid + r32; ATT_LOADQ(qn); }
            { const auto rr = __builtin_amdgcn_permlane32_swap(__float_as_uint(l_run), __float_as_uint(l_run), false, false); l_run = __uint_as_float(rr[0]) + __uint_as_float(rr[1]); }
            {
                const float inv = 1.0f / l_run;
                LAS unsigned char* stg = lds + 45056 + wid * 4608;
#pragma unroll
                for (int g = 0; g < 4; ++g) {
                    u32x2 w; w.x = cvtpk(o0[4 * g] * inv, o0[4 * g + 1] * inv); w.y = cvtpk(o0[4 * g + 2] * inv, o0[4 * g + 3] * inv); *(LAS u32x2*)(stg + r32 * 144 + (8 * g + 4 * hi) * 2) = w;
                    w.x = cvtpk(o1[4 * g] * inv, o1[4 * g + 1] * inv); w.y = cvtpk(o1[4 * g + 2] * inv, o1[4 * g + 3] * inv); *(LAS u32x2*)(stg + r32 * 144 + 64 + (8 * g + 4 * hi) * 2) = w;
                }
                asm volatile("s_waitcnt lgkmcnt(0)" ::: "memory");
#pragma unroll
                for (int i = 0; i < 4; ++i) {
                    const int row = i * 8 + (lane >> 3), ch = lane & 7, qq = qw0 + row;
                    const u32x4 v = *(const LAS u32x4*)(stg + row * 144 + ch * 16);
                    if (qq >= 0) *(u32x4*)(O + (size_t)(rowb + qq) * DM + h * 64 + ch * 8) = v;
                }
                asm volatile("s_waitcnt lgkmcnt(0)" ::: "memory");
            }
        }
#undef ATT_ITER
#undef ATT_BAR
#undef ATT_LOADQ
#undef ATT_LOADK
#undef ATT_LOADV
#undef ATT_STOREK
#undef ATT_STOREV
    }
}
}

__global__ void __launch_bounds__(512, 2) hybrid_fwd(Params p_unused) {
    extern __shared__ __attribute__((aligned(16))) unsigned char lds_raw[];
    LAS unsigned char* lds = (LAS unsigned char*)lds_raw;
    cg::grid_group grid = cg::this_grid();
    const KP kp0 = (KP)__builtin_amdgcn_kernarg_segment_ptr();
    const int G = (int)gridDim.x, bid = (int)blockIdx.x;
    const int wid0 = __builtin_amdgcn_readfirstlane((int)threadIdx.x >> 6);

#define GSYNC() gsync(kp0, lds, wid0)
    {
        const int t0 = tid_fresh(wid0);
        if (t0 < 4) ((LAS unsigned*)(lds + XBST_OFF))[t0] = 0u;
        __syncthreads();
        (void)xcd_barrier_post((unsigned*)kp0->ws, (volatile LAS unsigned*)(lds + XBST_OFF), t0);
    }
    prologue_weights(kp0, (LAS float*)lds, wid0);
    prologue_rope(kp0, wid0);
    row_init(kp0, wid0);
    grid.sync();

#pragma unroll 1
    for (int layer = 0; layer < DEPTH; ++layer) {
        const int jl = layer >> 1;
        if ((layer & 1) == 0) {
            {
                unsigned char* ws = kp_fresh(kp0)->ws;
                pg8::Gemm g{(const bf16*)(ws + WS_H16), (const bf16*)(ws + W_DQKV + jl * SZ_DQKV), 1024, 1024, 0, 256, 0, 1024}; int Gq = G, bq = bid; asm volatile("" : "+s"(Gq), "+s"(bq));
                pg8::StaticOrder S; S.init(RR, NDQKV, Gq, bq);
                pg8::EpiT1 E{(bf16*)(ws + WS_T1), (const float*)(ws + WS_RSTD), (float*)(ws + WS_PS)};
                pg8::gemm_phase<pg8::EpiT1, pg8::StaticOrder, true, true>(lds, g, S, E, wid0);
            }
            GSYNC();
            {
                unsigned char* ws = kp_fresh(kp0)->ws;
                const float* rcos = (const float*)(ws + WS_ROPE);
                pg8::Gemm g{(const bf16*)(ws + WS_T1), (const bf16*)(ws + W_UQ + jl * SZ_UQ), QLR, NDQKV, 0, 256, 0, QLR}; pg8::StaticOrder S; S.init(RR, 1536, G, bid);
                pg8::EpiQ E{(bf16*)(ws + WS_Q), rcos, rcos + LL * 16, (const float*)(ws + WS_PS), 0.10206207261596577f * 1.4426950408889634f, LL};
                pg8::gemm_phase<pg8::EpiQ, pg8::StaticOrder, true, true>(lds, g, S, E, wid0);
            }
            {
                unsigned char* ws = kp_fresh(kp0)->ws;
                pg8::Gemm g{(const bf16*)(ws + WS_T1) + QLR, (const bf16*)(ws + W_UKV + jl * SZ_UKV), KVLR, NDQKV, 0, 256, 0, KVLR}; pg8::StaticOrder S; S.init(RR, 2048, G, (bid + G / 2) % G);
                pg8::EpiStore E{(bf16*)(ws + WS_KV), 2048, (const float*)(ws + WS_PS), (float)KVLR, (const bf16*)(ws + WS_T1) + 640, (bf16*)(ws + WS_KR), (const float*)(ws + WS_ROPE), LL};
                pg8::gemm_phase<pg8::EpiStore, pg8::StaticOrder, true, true>(lds, g, S, E, wid0);
            }
            GSYNC();
            att::attn_phase(lds, kp0, wid0);
            GSYNC();
        }
#pragma unroll 1
        for (int half = 0; half < 2; ++half) {
            if (half == 1) {
                {
                    const KP kp = kp_fresh(kp0); unsigned char* ws = kp->ws;
                    pg8::Gemm g{(const bf16*)(ws + WS_H16), (const bf16*)(ws + W_UP + layer * SZ_UP), 1024, 1024, -2, UP_RSTEP, 0, 1024}; pg8::StaticOrder S; S.init(UP_TILES_M * 256, 5632, G, bid, 4);
                    pg8::EpiConv E{(bf16*)(ws + WS_G), kp->in[15] + (size_t)layer * 3 * 5632, kp->in[16] + (size_t)layer * 5632, (const float*)(ws + WS_RSTD), (LAS f32x4*)(lds + XCH_OFF), (LAS float*)(lds + XCH_OFF + 8192), (LAS float*)(lds + XCH_OFF + 8192 + 8192), -2, UP_RSTEP, RR, LL};
                    pg8::gemm_phase<pg8::EpiConv, pg8::StaticOrder, true, true>(lds, g, S, E, wid0);
                }
                GSYNC();
            }
            pg8::Gemm g;
            {
                unsigned char* ws = kp_fresh(kp0)->ws;
                if (half == 1)              g = pg8::Gemm{(const bf16*)(ws + WS_G), (const bf16*)(ws + W_DOWN + layer * SZ_DOWN), DFF, DFF, 0, 256, 0, DFF};
                else if ((layer & 1) == 0)  g = pg8::Gemm{(const bf16*)(ws + WS_O), (const bf16*)(ws + W_O + jl * SZ_O), 1024, 1024, 0, 256, 0, 1024};
                else                        g = pg8::Gemm{(const bf16*)(ws + WS_H16), (const bf16*)(ws + W_POOL + jl * SZ_POOL), 256, 1024, 0, 256, 512, 256};
            }
            {
                pg8::StaticOrder S; S.init(128 * 256, 1024, G, bid);
                unsigned char* ws = kp_fresh(kp0)->ws;
                pg8::EpiStore E{(bf16*)(ws + WS_MX), 1024, (half == 0 && (layer & 1)) ? (const float*)(ws + WS_RSTD) : nullptr, 0.f, nullptr, nullptr, nullptr, LL};
                pg8::gemm_phase<pg8::EpiStore, pg8::StaticOrder, true, true>(lds, g, S, E, wid0);
            }
            GSYNC();
            const int gpi = half == 0 ? 3 : 5; const bool hn = half == 0 ? true : (layer + 1 < DEPTH);
            const int ntail = half == 1 ? 8 : 4;
            if (bid < ntail) {
                const int ks = bid >> 2;
                unsigned char* ws = kp_fresh(kp0)->ws;
                pg8::Gemm gt = g; bf16* mxo = (bf16*)(ws + WS_MX);
                if (half == 1) { gt.A = g.A + ks * (DFF / 2); gt.Bt = g.Bt + ks * (DFF / 2); gt.K = DFF / 2; mxo = (bf16*)(ws + WS_MXT) + (size_t)ks * 256 * 1024 - (size_t)128 * 256 * 1024; }
                pg8::TailOrder S{128, 4, bid & 3};
                pg8::EpiStore E{mxo, 1024, (half == 0 && (layer & 1)) ? (const float*)(ws + WS_RSTD) : nullptr, 0.f, nullptr, nullptr, nullptr, LL};
                pg8::gemm_phase<pg8::EpiStore, pg8::TailOrder, true, true>(lds, gt, S, E, wid0);
                tail_barrier((unsigned*)kp_fresh(kp0)->ws + 3584 + 64 * (layer * 2 + half), tid_fresh(wid0), (unsigned)ntail);
                const int rpb = 256 / ntail;
                row_res(kp0, gpi, layer, hn, wid0, 128 * 256 + rpb * bid, 128 * 256 + rpb * bid + rpb, bid, 1, half == 1 ? 2 : 0, half == 0 && (layer & 1));
            } else {
                row_res(kp0, gpi, layer, hn, wid0, 0, 128 * 256, ntail, G - ntail, 0, half == 0 && (layer & 1));
            }
            if (!(half == 1 && layer + 1 == DEPTH)) GSYNC();
        }
    }
}

extern "C" void kernel_launch(void* const* d_in, const int* in_sizes, int n_in, void* d_out, int out_size, void* d_ws, size_t ws_size, hipStream_t stream) {
    static int grid = 0;
    if (grid == 0) {
        if (n_in != 18 || out_size != NB * SEQ * DM || ws_size < WS_END) { fprintf(stderr, "kernel_launch: unexpected problem (n_in %d out %d ws %zu need %zu)\n", n_in, out_size, ws_size, (size_t)WS_END); grid = -1; return; }
        int dev = 0, cus = 0, per_cu = 0;
        (void)hipGetDevice(&dev);
        (void)hipDeviceGetAttribute(&cus, hipDeviceAttributeMultiprocessorCount, dev);
        if (hipFuncSetAttribute((const void*)hybrid_fwd, hipFuncAttributeMaxDynamicSharedMemorySize, LDS_BYTES) != hipSuccess) { fprintf(stderr, "kernel_launch: hipFuncSetAttribute failed\n"); }
        if (hipOccupancyMaxActiveBlocksPerMultiprocessor(&per_cu, (const void*)hybrid_fwd, 512, LDS_BYTES) != hipSuccess || per_cu < 1) { fprintf(stderr, "kernel_launch: occupancy query says %d\n", per_cu); per_cu = 1; }
        (void)hipGetLastError();
        grid = cus * per_cu;
        if (grid > 256) grid = 256;
        if (grid < 1) grid = 256;
    }
    if (grid < 0) return;
    Params p{};
    for (int i = 0; i < 18; ++i) p.in[i] = (const float*)d_in[i];
    p.out = (float*)d_out; p.ws = (unsigned char*)d_ws;
    for (int e = 0; e < 16; ++e) p.inv_freq[e] = 1.0f / powf(10000.0f, (float)(2 * e) / 32.0f);
    if (hipMemsetAsync(d_ws, 0, 16384, stream) != hipSuccess) fprintf(stderr, "kernel_launch: memset of the barrier words failed\n");
    void* args[] = {&p};
    hipError_t e = hipLaunchCooperativeKernel((const void*)hybrid_fwd, dim3(grid), dim3(512), args, LDS_BYTES, stream);
    if (e != hipSuccess) fprintf(stderr, "cooperative launch failed: %s (grid %d)\n", hipGetErrorString(e), grid);
}
```

```cpp
#include <hip/hip_runtime.h>
#include <hip/hip_cooperative_groups.h>
#include <cstdio>
#include <cstdint>
namespace cg = cooperative_groups;

namespace pg8 {
#define PG8_LAS __attribute__((address_space(3)))
typedef unsigned short bf16_t;
typedef short bf16x8 __attribute__((ext_vector_type(8)));
typedef float f32x4 __attribute__((ext_vector_type(4)));
typedef unsigned u32x4 __attribute__((ext_vector_type(4)));
constexpr int BM = 256, BK = 64, HALF = 128, HTB = HALF * BK * 2  , STAGE_BYTES = 8 * HTB, NXCD = 8, WGM = 8;

__host__ __device__ __forceinline__ int lds_byte(int r, int c) { const int st = (r >> 4) * 2 + (c >> 5), rr = r & 15, cc = c & 31, ob = rr * 64 + cc * 2; return st * 1024 + (ob ^ (((ob >> 9) & 1) << 5)); }
__host__ __device__ __forceinline__ void stage_rc(int b, int& R, int& C) { const int st = b / 1024, sb = b % 1024, swz = sb ^ (((sb >> 9) & 1) << 5); R = (st >> 1) * 16 + swz / 64; C = (st & 1) * 32 + (swz % 64) / 2; }
__host__ __device__ __forceinline__ int perm32(int rho) { const int n = rho >> 4, i = rho & 15; return 8 * (i >> 2) + 4 * n + (i & 3); }

struct Unit { int pm, pn; };
struct Gemm { const bf16_t* A; const bf16_t* Bt; int K, lda, a_row0, a_rstep, a_pn_bytes, ldb; };

struct StaticOrder {
    int nM, nN, nwg, G, c, wgm;
    __host__ __device__ void init(int M, int N, int G_, int c_, int wgm_ = WGM) { nM = M / BM; nN = N / BM; nwg = nM * nN; G = G_; c = c_; wgm = wgm_; }
    __host__ __device__ bool next(int i, Unit& u) const {
        const long L = (long)i * G + c; if (L >= nwg) return false;
        int wgid = (int)L; { const int q = nwg / NXCD, r = nwg % NXCD, xcd = wgid % NXCD, off = wgid / NXCD; wgid = (xcd < r ? xcd * (q + 1) : r * (q + 1) + (xcd - r) * q) + off; }
        const int nig = wgm * nN, gid = wgid / nig, fm = gid * wgm, gsz = (nM - fm) < wgm ? (nM - fm) : wgm;
        u.pm = fm + ((wgid % nig) % gsz); u.pn = (wgid % nig) / gsz; return true;
    }
    __device__ __forceinline__ void a_ready(const Unit&) const {}
    __device__ __forceinline__ void done(const Unit&) const {}
};

struct TailOrder {
    int pm, nN, c;
    __device__ __forceinline__ bool next(int i, Unit& u) const { if (i > 0 || c >= nN) return false; u.pm = pm; u.pn = c; return true; }
    __device__ __forceinline__ void a_ready(const Unit&) const {}
    __device__ __forceinline__ void done(const Unit&) const {}
};

__device__ __forceinline__ unsigned cvt_pk_bf16(float lo, float hi) { unsigned r; asm volatile("v_cvt_pk_bf16_f32 %0, %1, %2" : "=v"(r) : "v"(lo), "v"(hi)); return r; }

typedef unsigned u32x2 __attribute__((ext_vector_type(2)));
typedef float cv_f32x2 __attribute__((ext_vector_type(2))); typedef __bf16 cv_bf16x2 __attribute__((ext_vector_type(2)));
__device__ __forceinline__ unsigned cvt_pk_bf16_b(float lo, float hi) { const cv_f32x2 v = {lo, hi}; const cv_bf16x2 b = __builtin_convertvector(v, cv_bf16x2); return __builtin_bit_cast(unsigned, b); }

struct EpiStore {
    static constexpr bool PERM = true, AFTER_DRAIN = false, ROWPERM = false, PREFETCH = false;
    bf16_t* O; int ldc; const float* rs; float rsdiv; const bf16_t* kr_src; bf16_t* kr_dst; const float* rcos; int seqlen;
    __device__ __forceinline__ void operator()(const f32x4 (&acc)[2][2][4][2], const Unit& u, int wr, int wc, int fr_, int fq_) const {
        (void)fr_; (void)fq_; int l_; asm volatile("v_mbcnt_lo_u32_b32 %0, -1, 0\n\tv_mbcnt_hi_u32_b32 %0, -1, %0" : "=v"(l_));
        const int fr = l_ & 15, fq = l_ >> 4;
        const int row0 = u.pm * BM + wr * 64 + fr; const int col0 = u.pn * BM + wc * 32 + 8 * fq;
#pragma unroll
        for (int ai = 0; ai < 2; ++ai)
#pragma unroll
            for (int m = 0; m < 4; ++m) { bf16_t* rowp = O + (size_t)(row0 + ai * HALF + m * 16) * ldc + col0; float sc = 1.0f;
                if (rsdiv > 0.f) { const float* pp = rs + (size_t)(row0 + ai * HALF + m * 16) * 20 + 12; const f32x4 pa = *(const f32x4*)pp, pb = *(const f32x4*)(pp + 4);
                    sc = 1.0f / sqrtf((((pa[0] + pa[1]) + (pa[2] + pa[3])) + ((pb[0] + pb[1]) + (pb[2] + pb[3]))) / rsdiv + 1e-6f); }
                else if (rs) sc = rs[row0 + ai * HALF + m * 16];
#pragma unroll
                for (int bj = 0; bj < 2; ++bj) { const f32x4 v0 = acc[ai][bj][m][0] * sc, v1 = acc[ai][bj][m][1] * sc;
                    u32x4 w; w.x = cvt_pk_bf16(v0[0], v0[1]); w.y = cvt_pk_bf16(v0[2], v0[3]); w.z = cvt_pk_bf16(v1[0], v1[1]); w.w = cvt_pk_bf16(v1[2], v1[3]);
                    *(u32x4*)(rowp + bj * HALF) = w; } }
        if (kr_src && u.pn == 0) {
            const int tid = l_ + 64 * (wr * 4 + wc), row = u.pm * BM + (tid >> 1), i0 = (tid & 1) * 8, t = row % seqlen;
            const bf16_t* sp = kr_src + (size_t)row * 768; bf16_t* dp = kr_dst + (size_t)row * 32; const float* cp = rcos + t * 16; const float* snp = cp + seqlen * 16;
            const u32x4 a4 = *(const u32x4*)(sp + i0), b4 = *(const u32x4*)(sp + 16 + i0);
            const unsigned aw[4] = {a4.x, a4.y, a4.z, a4.w}, bw[4] = {b4.x, b4.y, b4.z, b4.w};
            unsigned o1[4], o2[4];
#pragma unroll
            for (int q = 0; q < 4; ++q) {
                const float x1a = __uint_as_float(aw[q] << 16), x1b = __uint_as_float(aw[q] & 0xffff0000u), x2a = __uint_as_float(bw[q] << 16), x2b = __uint_as_float(bw[q] & 0xffff0000u);
                const float ca = cp[i0 + 2 * q], cb = cp[i0 + 2 * q + 1], sa = snp[i0 + 2 * q], sb = snp[i0 + 2 * q + 1];
                o1[q] = cvt_pk_bf16(x1a * ca - x2a * sa, x1b * cb - x2b * sb); o2[q] = cvt_pk_bf16(x2a * ca + x1a * sa, x2b * cb + x1b * sb); }
            u32x4 w1, w2; w1.x = o1[0]; w1.y = o1[1]; w1.z = o1[2]; w1.w = o1[3]; w2.x = o2[0]; w2.y = o2[1]; w2.z = o2[2]; w2.w = o2[3];
            *(u32x4*)(dp + i0) = w1; *(u32x4*)(dp + 16 + i0) = w2;
        }
    }
};

struct EpiT1 {
    static constexpr bool PERM = true, AFTER_DRAIN = false, ROWPERM = false, PREFETCH = false;
    bf16_t* O; const float* rs; float* ps;
    __device__ __forceinline__ void operator()(const f32x4 (&acc)[2][2][4][2], const Unit& u, int wr, int wc, int fr_, int fq_) const {
        (void)fr_; (void)fq_; int l_; asm volatile("v_mbcnt_lo_u32_b32 %0, -1, 0\n\tv_mbcnt_hi_u32_b32 %0, -1, %0" : "=v"(l_));
        const int fr = l_ & 15, fq = l_ >> 4;
        const int row0 = u.pm * BM + wr * 64 + fr; const int col0 = u.pn * BM + wc * 32 + 8 * fq;
        const int kind0 = u.pn == 2 ? 1 : 0, kind1 = u.pn == 0 ? 0 : (u.pn == 1 ? 1 : 2);
#pragma unroll
        for (int ai = 0; ai < 2; ++ai)
#pragma unroll
            for (int m = 0; m < 4; ++m) { const int row = row0 + ai * HALF + m * 16; bf16_t* rowp = O + (size_t)row * 768 + col0; const float sc = rs[row];
#pragma unroll
                for (int bj = 0; bj < 2; ++bj) { const f32x4 v0 = acc[ai][bj][m][0] * sc, v1 = acc[ai][bj][m][1] * sc;
                    u32x4 w; w.x = cvt_pk_bf16(v0[0], v0[1]); w.y = cvt_pk_bf16(v0[2], v0[3]); w.z = cvt_pk_bf16(v1[0], v1[1]); w.w = cvt_pk_bf16(v1[2], v1[3]);
                    *(u32x4*)(rowp + bj * HALF) = w;
                    float p = v0[0] * v0[0] + v0[1] * v0[1] + v0[2] * v0[2] + v0[3] * v0[3] + v1[0] * v1[0] + v1[1] * v1[1] + v1[2] * v1[2] + v1[3] * v1[3];
                    p += __int_as_float(__builtin_amdgcn_ds_bpermute((l_ ^ 16) << 2, __float_as_int(p)));
                    p += __int_as_float(__builtin_amdgcn_ds_bpermute((l_ ^ 32) << 2, __float_as_int(p)));
                    const int kind = bj == 0 ? kind0 : kind1;
                    const int slot = kind == 0 ? (u.pn == 0 ? bj * 4 + wc : 8 + wc) : 12 + (u.pn == 1 ? wc : 4 + wc);
                    if (fq == 0 && kind < 2) ps[(size_t)row * 20 + slot] = p; } }
    }
};

struct EpiQ {
    static constexpr bool PERM = false, AFTER_DRAIN = false, ROWPERM = false, PREFETCH = false;
    bf16_t* O; const float* rcos; const float* rsin; const float* rs; float sc0; int seqlen;
    __device__ __forceinline__ void operator()(const f32x4 (&acc)[2][2][4][2], const Unit& u, int wr, int wc, int fr, int fq) const {
#pragma unroll
        for (int ai = 0; ai < 2; ++ai)
#pragma unroll
            for (int m = 0; m < 4; ++m) {
                const int row = u.pm * BM + ai * HALF + wr * 64 + m * 16 + fr;
                const f32x4 pa = *(const f32x4*)(rs + (size_t)row * 20), pb = *(const f32x4*)(rs + (size_t)row * 20 + 4), pc = *(const f32x4*)(rs + (size_t)row * 20 + 8);
                const float ssq = ((pa[0] + pa[1]) + (pa[2] + pa[3])) + ((pb[0] + pb[1]) + (pb[2] + pb[3])) + ((pc[0] + pc[1]) + (pc[2] + pc[3]));
                const float sc = sc0 / sqrtf(ssq * (1.0f / 384.0f) + 1e-6f);
                bf16_t* rowp = O + (size_t)row * 1536 + u.pn * BM + wc * 32 + 4 * fq;
                bf16_t* rowq = O + (size_t)row * 1536 + u.pn * BM + wc * 32 + ((fq & 1) ? 16 + 4 * (fq - 1) : 4 * fq);
                f32x4 c4 = (f32x4){1.f, 1.f, 1.f, 1.f}, s4 = (f32x4){0.f, 0.f, 0.f, 0.f};
                if (u.pn >= 4) { const int t = row % seqlen; c4 = *(const f32x4*)(rcos + t * 16 + 4 * fq); s4 = *(const f32x4*)(rsin + t * 16 + 4 * fq); }
#pragma unroll
                for (int bj = 0; bj < 2; ++bj) { const f32x4 x1 = acc[ai][bj][m][0], x2 = acc[ai][bj][m][1];
                    f32x4 o1, o2;
                    if (u.pn < 4) { o1 = x1 * sc; o2 = x2 * sc; } else { o1 = (x1 * c4 - x2 * s4) * sc; o2 = (x2 * c4 + x1 * s4) * sc; }
                    unsigned ax = cvt_pk_bf16_b(o1[0], o1[1]), ay = cvt_pk_bf16_b(o1[2], o1[3]), bx = cvt_pk_bf16_b(o2[0], o2[1]), by = cvt_pk_bf16_b(o2[2], o2[3]);
                    { const auto r = __builtin_amdgcn_permlane16_swap(ax, bx, false, false); ax = r[0]; bx = r[1]; }
                    { const auto r = __builtin_amdgcn_permlane16_swap(ay, by, false, false); ay = r[0]; by = r[1]; }
                    u32x4 w; w.x = ax; w.y = ay; w.z = bx; w.w = by;
                    *(u32x4*)(rowq + bj * HALF) = w; }
            }
    }
};

struct EpiConv {
    static constexpr bool PERM = true, AFTER_DRAIN = false, ROWPERM = true, PREFETCH = true;
    bf16_t* G; const float* cw; const float* cb; const float* rs; PG8_LAS f32x4* xch; PG8_LAS float* wl2; PG8_LAS float* rsl2; int a_row0, a_rstep, nrows, seqlen;
    static __device__ __forceinline__ int xi(int wr, int wc, int ai, int s, int bj, int n, int fq) { return (((((wr * 4 + wc) * 2 + ai) * 2 + s) * 2 + bj) * 2 + n) * 4 + fq; }
    __device__ __forceinline__ void prefetch(const Unit& u, int par, int wid, int lane_) const {
        (void)lane_; int lane; asm volatile("v_mbcnt_lo_u32_b32 %0, -1, 0\n\tv_mbcnt_hi_u32_b32 %0, -1, %0" : "=v"(lane));
        if (wid < 4) { const int c = lane * 4; const float* sp = (wid < 3 ? cw + wid * 5632 : cb) + (c >> 7) * 2816 + u.pn * 128 + (c & 127);
            __builtin_amdgcn_global_load_lds((const unsigned*)sp, (PG8_LAS unsigned*)(wl2 + par * 1024 + wid * 256), 16, 0, 0); }
        else { int gr = a_row0 + u.pm * a_rstep + (wid - 4) * 64 + lane; gr = gr < 0 ? 0 : (gr < nrows ? gr : nrows - 1);
            __builtin_amdgcn_global_load_lds((const unsigned*)(rs + gr), (PG8_LAS unsigned*)(rsl2 + par * 256 + (wid - 4) * 64), 4, 0, 0); }
    }
    __device__ __forceinline__ void run(f32x4 (&acc)[2][2][4][2], const Unit& u, int wr, int wc, int fr_, int fq_, int par) const {
        (void)fr_; (void)fq_; int l_; asm volatile("v_mbcnt_lo_u32_b32 %0, -1, 0\n\tv_mbcnt_hi_u32_b32 %0, -1, %0" : "=v"(l_));
        const int fr = l_ & 15, fq = l_ >> 4;
        const int lane = fr + 16 * fq;
        const PG8_LAS float* wl = wl2 + par * 1024; const PG8_LAS float* rsl = rsl2 + par * 256;
#pragma unroll
        for (int ai = 0; ai < 2; ++ai)
#pragma unroll
            for (int m = 0; m < 4; ++m) { const float sc = rsl[ai * HALF + wr * 64 + 4 * fr + m];
#pragma unroll
                for (int bj = 0; bj < 2; ++bj)
#pragma unroll
                    for (int n = 0; n < 2; ++n) acc[ai][bj][m][n] = acc[ai][bj][m][n] * sc; }
        if (fr == 15) {
#pragma unroll
            for (int ai = 0; ai < 2; ++ai)
#pragma unroll
                for (int bj = 0; bj < 2; ++bj)
#pragma unroll
                    for (int n = 0; n < 2; ++n) { xch[xi(wr, wc, ai, 0, bj, n, fq)] = acc[ai][bj][2][n]; xch[xi(wr, wc, ai, 1, bj, n, fq)] = acc[ai][bj][3][n]; }
        }
        asm volatile("s_waitcnt lgkmcnt(0)" ::: "memory"); __builtin_amdgcn_s_barrier(); asm volatile("" ::: "memory");
        const int src = (lane & 48) | ((fr + 15) & 15);
        const f32x4 z4 = (f32x4){0.f, 0.f, 0.f, 0.f};
        const PG8_LAS float* wlane = wl + wc * 32 + 8 * fq;
        const int cu = u.pn * 128 + wc * 32;
#pragma unroll
        for (int ai = 0; ai < 2; ++ai) {
            const bool has_prev = (wr | ai) != 0;
            const int swr = wr ^ 1, sai = wr ? ai : 0;
            const int growu = a_row0 + u.pm * a_rstep + ai * HALF + wr * 64;
            const int grow0 = growu + 4 * fr;
            const int tz = ((grow0 % seqlen) + seqlen) % seqlen;
#define PG8_Z0(m_) ((tz + (m_)) == 0 || (tz + (m_)) == seqlen)
#define PG8_Z1(m_) ((tz + (m_)) == 1 || (tz + (m_)) == seqlen + 1)
#define PG8_CONV_RUN(EDGE_) do { \
            _Pragma("unroll") for (int bj = 0; bj < 2; ++bj) { \
                _Pragma("unroll") for (int n = 0; n < 2; ++n) { \
                    const PG8_LAS float* wq = wlane + bj * 128 + 4 * n; \
                    const f32x4 w0 = *(const PG8_LAS f32x4*)(wq), w1 = *(const PG8_LAS f32x4*)(wq + 256), w2 = *(const PG8_LAS f32x4*)(wq + 512), bb = *(const PG8_LAS f32x4*)(wq + 768); \
                    const f32x4 v0 = acc[ai][bj][0][n], v1 = acc[ai][bj][1][n], v2 = acc[ai][bj][2][n], v3 = acc[ai][bj][3][n]; \
                      \
                    const f32x4 h2 = has_prev ? xch[xi(swr, wc, sai, 0, bj, n, fq)] : z4, h3 = has_prev ? xch[xi(swr, wc, sai, 1, bj, n, fq)] : z4; \
                    f32x4 s2, s3; \
                    _Pragma("unroll") for (int j = 0; j < 4; ++j) { const float t2 = v2[j], t3 = v3[j], o2 = h2[j], o3 = h3[j]; \
                        s2[j] = __int_as_float(__builtin_amdgcn_update_dpp(__float_as_int(o2), __float_as_int(t2), 0x111, 0xf, 0xf, false)); \
                        s3[j] = __int_as_float(__builtin_amdgcn_update_dpp(__float_as_int(o3), __float_as_int(t3), 0x111, 0xf, 0xf, false)); } \
                    f32x4 a, b; \
                    a = s2; b = s3; if (EDGE_) { if (PG8_Z0(0)) { a = z4; b = z4; } else if (PG8_Z1(0)) a = z4; } \
                    acc[ai][bj][0][n] = bb + w0 * a + w1 * b + w2 * v0; \
                    a = s3; b = v0; if (EDGE_) { if (PG8_Z0(1)) { a = z4; b = z4; } else if (PG8_Z1(1)) a = z4; } \
                    acc[ai][bj][1][n] = bb + w0 * a + w1 * b + w2 * v1; \
                    a = v0; b = v1; if (EDGE_) { if (PG8_Z0(2)) { a = z4; b = z4; } else if (PG8_Z1(2)) a = z4; } \
                    acc[ai][bj][2][n] = bb + w0 * a + w1 * b + w2 * v2; \
                    a = v1; b = v2; if (EDGE_) { if (PG8_Z0(3)) { a = z4; b = z4; } else if (PG8_Z1(3)) a = z4; } \
                    acc[ai][bj][3][n] = bb + w0 * a + w1 * b + w2 * v3; \
                    asm volatile("" ::: "memory"); \
                    __builtin_amdgcn_sched_barrier(0); \
                } \
            } } while (0)
            if (__builtin_amdgcn_ballot_w64(tz < 2 || tz + 3 >= seqlen) != 0ull) PG8_CONV_RUN(true); else PG8_CONV_RUN(false);
#undef PG8_CONV_RUN
#undef PG8_Z0
#undef PG8_Z1
            char* gb = (char*)(G + (long)growu * 2816 + cu);
#pragma unroll
            for (int m = 0; m < 4; ++m) {
                const int grow = grow0 + m, rl = ai * HALF + wr * 64 + 4 * fr + m;
                if (rl >= 2 && grow < nrows) {
                    u32x4 w; float o[8];
#pragma unroll
                    for (int n = 0; n < 2; ++n)
#pragma unroll
                        for (int j = 0; j < 4; ++j) { const float g = acc[ai][0][m][n][j], x = acc[ai][1][m][n][j]; o[n * 4 + j] = g * __builtin_amdgcn_rcpf(1.0f + __expf(-g)) * x; }
                    w.x = cvt_pk_bf16(o[0], o[1]); w.y = cvt_pk_bf16(o[2], o[3]); w.z = cvt_pk_bf16(o[4], o[5]); w.w = cvt_pk_bf16(o[6], o[7]);
                    *(u32x4*)(gb + (unsigned)(((4 * fr + m) * 2816 + 8 * fq) * 2)) = w;
                }
                __builtin_amdgcn_sched_barrier(0);
            }
        }
    }
};

template <class Epi, class Sched, bool ALIGN_EPI = false, bool SP2 = false>
__device__ __forceinline__ void gemm_phase(PG8_LAS unsigned char* lds, const Gemm g, const Sched& S, const Epi& E, int wid0) {
    int tid_; asm volatile("v_mbcnt_lo_u32_b32 %0, -1, 0\n\tv_mbcnt_hi_u32_b32 %0, -1, %0" : "=v"(tid_)); tid_ += wid0 * 64;
    const int tid = tid_, wid = __builtin_amdgcn_readfirstlane(tid >> 6), lane = tid & 63, wr = wid >> 2, wc = wid & 3, fr = lane & 15, fq = lane >> 4;
    const int K = g.K, nt = K / BK, lda = g.lda, ldb = g.ldb;
    unsigned voffA, voffB;
    { int R, C; stage_rc(tid * 16, R, C); const int Rb = Epi::PERM ? ((R & ~31) + perm32(R & 31)) : R;
        const int Ra = Epi::ROWPERM ? ((R & 64) | ((R & 15) << 2) | ((R >> 4) & 3)) : R;
        voffA = (unsigned)(Ra * lda + C) * 2u; voffB = (unsigned)(Rb * ldb + C) * 2u; }
    const size_t r64voffA = (size_t)64 * lda * 2, r64voffB = (size_t)64 * ldb * 2;
    const size_t kstep = (size_t)(BK * 2);
    const size_t hstepB = (size_t)HALF * ldb * 2, hstepA = (size_t)HALF * lda * 2;
    const size_t tstepB = 2 * hstepB;
#define PG8_APTR(u_) ((const char*)g.A + ((long)g.a_row0 + (long)(u_).pm * g.a_rstep) * (long)lda * 2 + (long)(u_).pn * g.a_pn_bytes)
    const unsigned ldsw = (unsigned)wid * 1024u;
    const int aoff = lds_byte(wr * 64 + fr, fq * 8), boff = lds_byte(wc * 32 + fr, fq * 8);
#define PG8_SA(b, h) (((b) * 2 + (h)) * HTB)
#define PG8_SB(b, h) ((4 + (b) * 2 + (h)) * HTB)
#define PG8_STAGE(bufoff, gbase, voff) do { _Pragma("unroll") for (int _i = 0; _i < 2; ++_i) \
        __builtin_amdgcn_global_load_lds((const unsigned*)((const char*)(gbase) + (size_t)_i * r64##voff + voff), (PG8_LAS unsigned*)(lds + (bufoff) + ldsw + _i * 8192), 16, 0, 0); } while (0)
#define PG8_LDA(dst, b, h) do { _Pragma("unroll") for (int m = 0; m < 4; ++m) _Pragma("unroll") for (int k = 0; k < 2; ++k) dst[m][k] = *(const PG8_LAS bf16x8*)(lds + PG8_SA(b, h) + aoff + m * 2048 + k * 1024); } while (0)
#define PG8_LDB(dst, b, h) do { _Pragma("unroll") for (int n = 0; n < 2; ++n) _Pragma("unroll") for (int k = 0; k < 2; ++k) dst[n][k] = *(const PG8_LAS bf16x8*)(lds + PG8_SB(b, h) + boff + n * 2048 + k * 1024); } while (0)
#define PG8_MMA(ai, bj, At, Bt) do { __builtin_amdgcn_s_setprio(1); _Pragma("unroll") for (int m = 0; m < 4; ++m) _Pragma("unroll") for (int n = 0; n < 2; ++n) _Pragma("unroll") for (int k = 0; k < 2; ++k) \
        acc[ai][bj][m][n] = __builtin_amdgcn_mfma_f32_16x16x32_bf16(Bt[n][k], At[m][k], acc[ai][bj][m][n], 0, 0, 0); __builtin_amdgcn_s_setprio(0); } while (0)
#define PG8_WAIT_V(n) asm volatile("s_waitcnt vmcnt(" #n ")" ::: "memory")
#define PG8_WAIT_L(n) asm volatile("s_waitcnt lgkmcnt(" #n ")" ::: "memory")
#define PG8_BAR __builtin_amdgcn_s_barrier()
#define PG8_SCHED __builtin_amdgcn_sched_barrier(0)
    Unit cur, nxt; int ui = 0;
    if (!S.next(0, cur)) return;
    f32x4 acc[2][2][4][2];
#pragma unroll
    for (int a = 0; a < 2; ++a)
#pragma unroll
        for (int b = 0; b < 2; ++b)
#pragma unroll
            for (int m = 0; m < 4; ++m)
#pragma unroll
                for (int n = 0; n < 2; ++n) acc[a][b][m][n] = (f32x4){0.f, 0.f, 0.f, 0.f};
    bf16x8 At[4][2], B0[2][2], B1[2][2];
    const char* cA = PG8_APTR(cur); const char* cB = (const char*)g.Bt + (size_t)cur.pn * tstepB;
    S.a_ready(cur);
    if constexpr (Epi::PREFETCH) E.prefetch(cur, 0, wid, lane);
    if constexpr (SP2) {
        PG8_STAGE(PG8_SB(0, 0), cB, voffB); PG8_STAGE(PG8_SB(0, 1), cB + hstepB, voffB); PG8_STAGE(PG8_SA(0, 0), cA, voffA); PG8_STAGE(PG8_SA(0, 1), cA + hstepA, voffA);
        if (wr == 1) PG8_BAR;
        PG8_WAIT_V(2); PG8_BAR;
        PG8_STAGE(PG8_SB(1, 0), cB + kstep, voffB); PG8_STAGE(PG8_SA(1, 0), cA + kstep, voffA); PG8_STAGE(PG8_SB(1, 1), cB + hstepB + kstep, voffB);
        PG8_WAIT_V(6); PG8_BAR;
    } else {
        PG8_STAGE(PG8_SB(0, 0), cB, voffB); PG8_STAGE(PG8_SA(0, 0), cA, voffA); PG8_STAGE(PG8_SB(0, 1), cB + hstepB, voffB); PG8_STAGE(PG8_SA(0, 1), cA + hstepA, voffA);
        if (wr == 1) PG8_BAR;
        PG8_WAIT_V(4); PG8_BAR;
        PG8_STAGE(PG8_SB(1, 0), cB + kstep, voffB); PG8_STAGE(PG8_SA(1, 0), cA + kstep, voffA); PG8_STAGE(PG8_SB(1, 1), cB + hstepB + kstep, voffB);
        PG8_WAIT_V(6); PG8_BAR;
    }
    for (;;) {
        const bool has_next = S.next(ui + 1, nxt);
        const char* nA = has_next ? PG8_APTR(nxt) : cA; const char* nB = has_next ? (const char*)g.Bt + (size_t)nxt.pn * tstepB : cB;
        for (int t = 0; t < nt; t += 2) {
            const bool last = (t == nt - 2);
            const char* a1 = cA + (size_t)(t + 1) * kstep;
            const char* a2 = last ? nA : cA + (size_t)(t + 2) * kstep; const char* b2 = last ? nB : cB + (size_t)(t + 2) * kstep;
            const char* a3 = a2 + kstep; const char* b3 = b2 + kstep;
            if (last && has_next) S.a_ready(nxt);
            if constexpr (SP2) {
            PG8_LDB(B0, 0, 0); PG8_LDB(B1, 0, 1); PG8_SCHED; PG8_LDA(At, 0, 0); PG8_STAGE(PG8_SA(1, 1), a1 + hstepA, voffA);
            PG8_WAIT_V(8); PG8_WAIT_L(0); PG8_BAR; PG8_MMA(0, 0, At, B0); PG8_MMA(0, 1, At, B1); PG8_BAR; PG8_SCHED;
            PG8_LDA(At, 0, 1); PG8_STAGE(PG8_SB(0, 0), b2, voffB); PG8_STAGE(PG8_SB(0, 1), b2 + hstepB, voffB); PG8_STAGE(PG8_SA(0, 0), a2, voffA);
            PG8_WAIT_V(8); PG8_WAIT_L(0); PG8_BAR; PG8_MMA(1, 0, At, B0); PG8_MMA(1, 1, At, B1); PG8_BAR; PG8_SCHED;
            PG8_LDB(B0, 1, 0); PG8_LDB(B1, 1, 1); PG8_SCHED; PG8_LDA(At, 1, 0); PG8_STAGE(PG8_SA(0, 1), a2 + hstepA, voffA);
            PG8_WAIT_V(8); PG8_WAIT_L(0); PG8_BAR; PG8_MMA(0, 0, At, B0); PG8_MMA(0, 1, At, B1); PG8_BAR; PG8_SCHED;
            PG8_LDA(At, 1, 1); PG8_STAGE(PG8_SB(1, 0), b3, voffB); PG8_STAGE(PG8_SB(1, 1), b3 + hstepB, voffB); PG8_STAGE(PG8_SA(1, 0), a3, voffA);
            PG8_WAIT_V(8); PG8_WAIT_L(0); PG8_BAR; PG8_MMA(1, 0, At, B0); PG8_MMA(1, 1, At, B1); PG8_BAR; PG8_SCHED;
            } else {
            PG8_LDB(B0, 0, 0); PG8_SCHED; PG8_LDA(At, 0, 0); PG8_STAGE(PG8_SA(1, 1), a1 + hstepA, voffA);
            PG8_WAIT_L(8); PG8_BAR; PG8_WAIT_L(0); PG8_MMA(0, 0, At, B0); PG8_BAR; PG8_SCHED;
            PG8_LDB(B1, 0, 1); PG8_STAGE(PG8_SB(0, 0), b2, voffB);
            PG8_BAR; PG8_WAIT_L(0); PG8_MMA(0, 1, At, B1); PG8_BAR;
            PG8_LDA(At, 0, 1); PG8_STAGE(PG8_SA(0, 0), a2, voffA);
            PG8_BAR; PG8_WAIT_L(0); PG8_MMA(1, 0, At, B0); PG8_BAR; PG8_SCHED;
            PG8_STAGE(PG8_SB(0, 1), b2 + hstepB, voffB);
            PG8_WAIT_V(6); PG8_BAR; PG8_MMA(1, 1, At, B1); PG8_BAR;
            PG8_LDB(B0, 1, 0); PG8_SCHED; PG8_LDA(At, 1, 0); PG8_STAGE(PG8_SA(0, 1), a2 + hstepA, voffA);
            PG8_WAIT_L(8); PG8_BAR; PG8_WAIT_L(0); PG8_MMA(0, 0, At, B0); PG8_BAR; PG8_SCHED;
            PG8_LDB(B1, 1, 1); PG8_STAGE(PG8_SB(1, 0), b3, voffB);
            PG8_BAR; PG8_WAIT_L(0); PG8_MMA(0, 1, At, B1); PG8_BAR;
            PG8_LDA(At, 1, 1); PG8_STAGE(PG8_SA(1, 0), a3, voffA);
            PG8_BAR; PG8_WAIT_L(0); PG8_MMA(1, 0, At, B0); PG8_BAR; PG8_SCHED;
            PG8_STAGE(PG8_SB(1, 1), b3 + hstepB, voffB);
            PG8_WAIT_V(6); PG8_BAR; PG8_MMA(1, 1, At, B1); PG8_BAR;
            }
        }
        if constexpr (ALIGN_EPI) { if (wr == 0) PG8_BAR; }
        if constexpr (!Epi::AFTER_DRAIN) { if constexpr (Epi::PREFETCH) E.run(acc, cur, wr, wc, fr, fq, ui & 1); else E(acc, cur, wr, wc, fr, fq); S.done(cur); }
        if (!has_next) break;
#pragma unroll
        for (int a = 0; a < 2; ++a)
#pragma unroll
            for (int b = 0; b < 2; ++b)
#pragma unroll
                for (int m = 0; m < 4; ++m)
#pragma unroll
                    for (int n = 0; n < 2; ++n) acc[a][b][m][n] = (f32x4){0.f, 0.f, 0.f, 0.f};
        cur = nxt; cA = nA; cB = nB; ++ui;
        if constexpr (Epi::PREFETCH) E.prefetch(cur, ui & 1, wid, lane);
        if constexpr (ALIGN_EPI) { if (wr == 1) PG8_BAR; }
    }
    PG8_WAIT_V(0);
    if constexpr (!ALIGN_EPI) { if (wr == 0) PG8_BAR; }
    PG8_BAR;
    if constexpr (Epi::AFTER_DRAIN) { E.fused(acc, cur, wr, wc, fr, fq, lds, wid, lane); S.done(cur); }
#undef PG8_APTR
#undef PG8_SA
#undef PG8_SB
#undef PG8_STAGE
#undef PG8_LDA
#undef PG8_LDB
#undef PG8_MMA
#undef PG8_WAIT_V
#undef PG8_WAIT_L
#undef PG8_BAR
#undef PG8_SCHED
}
}

#define LAS __attribute__((address_space(3)))
typedef unsigned short bf16;
typedef float f32x4 __attribute__((ext_vector_type(4)));
typedef float f32x16 __attribute__((ext_vector_type(16)));
typedef short bf16x8 __attribute__((ext_vector_type(8)));
typedef short s16x4 __attribute__((ext_vector_type(4)));
typedef unsigned u32x4 __attribute__((ext_vector_type(4)));
typedef unsigned u32x2 __attribute__((ext_vector_type(2)));

constexpr int NB = 16, SEQ = 2048, DM = 1024, NMETA = 16, LL = NMETA + SEQ  , RR = NB * LL  ;
constexpr int NHD = 16, QLR = 384, KVLR = 256, DFF = 2816, DEPTH = 4;
constexpr int NDQKV = 768;
constexpr float NORM_EPS = 1e-6f;
constexpr int UP_TILES_M = 131, UP_RSTEP = 254;
static_assert(RR % 256 == 0 && (UP_TILES_M * UP_RSTEP) >= RR, "tiling");

constexpr size_t MiB = 1u << 20;
constexpr size_t WS_ROPE = 1 * MiB;
constexpr size_t WS_MXT = 2 * MiB;
constexpr size_t SZ_UP = 5632ull * 1024 * 2, SZ_DOWN = 1024ull * 2816 * 2, SZ_DQKV = 768ull * 1024 * 2, SZ_UQ = 1536ull * 384 * 2, SZ_UKV = 2048ull * 256 * 2, SZ_O = 1024ull * 1024 * 2, SZ_POOL = 1024ull * 256 * 2;
constexpr size_t W_UP = 4 * MiB, W_DOWN = W_UP + 4 * SZ_UP, W_DQKV = W_DOWN + 4 * SZ_DOWN, W_UQ = W_DQKV + 2 * SZ_DQKV, W_UKV = W_UQ + 2 * SZ_UQ, W_O = W_UKV + 2 * SZ_UKV, W_POOL = W_O + 2 * SZ_O, W_END = W_POOL + 2 * SZ_POOL;
constexpr size_t WS_X0 = (W_END + MiB - 1) / MiB * MiB;
constexpr size_t WS_T1 = WS_X0, WS_CQ = WS_T1 + (size_t)RR * 768 * 2, WS_CKV = WS_CQ + (size_t)RR * 384 * 2, WS_KR = WS_CKV + (size_t)RR * 256 * 2;
constexpr size_t WS_Q = WS_KR + (size_t)RR * 32 * 2, WS_KV = WS_Q + (size_t)RR * 1536 * 2, WS_APAD = WS_KV + (size_t)RR * 2048 * 2;
constexpr size_t WS_H16 = WS_APAD, WS_END = WS_H16 + (size_t)(RR + 512) * 1024 * 2;
constexpr size_t WS_PS = WS_X0 + (size_t)RR * 768 * 2 + (size_t)RR * 384 * 2;
constexpr size_t WS_RSQ = 1 * MiB + 672 * 1024, WS_RSK = 1 * MiB + 832 * 1024;
constexpr size_t WS_RSTD = 1 * MiB + 512 * 1024;
constexpr size_t WS_O = WS_T1;
constexpr size_t WS_MX = WS_KV;
constexpr size_t WS_G = WS_X0;
constexpr size_t WS_MIX = WS_X0;
static_assert(WS_O + (size_t)RR * 1024 * 2 <= WS_CKV, "O overlays T1|CQ only");
static_assert(WS_G + (size_t)RR * 2816 * 2 <= WS_KV, "G overlays T1..Q only");

constexpr int LDS_BYTES = 155648;
constexpr int XCH_OFF = 131072 + 1024;

struct Params { const float* in[18]; float* out; unsigned char* ws; float inv_freq[16]; };
typedef const __attribute__((address_space(4))) Params* KP;
__device__ __forceinline__ KP kp_fresh(KP k) { asm volatile("" : "+s"(k)); return k; }
__device__ __forceinline__ int lane_id() { int l; asm volatile("v_mbcnt_lo_u32_b32 %0, -1, 0\n\tv_mbcnt_hi_u32_b32 %0, -1, %0" : "=v"(l)); return l; }
__device__ __forceinline__ float lane_xchg(float v, int srclane) { return __builtin_bit_cast(float, __builtin_amdgcn_ds_bpermute(srclane << 2, __builtin_bit_cast(int, v))); }
__device__ __forceinline__ int tid_fresh(int wid) { return wid * 64 + lane_id(); }

__device__ __forceinline__ unsigned f2bf(float f) { unsigned u = __builtin_bit_cast(unsigned, f); return (u + 0x7fffu + ((u >> 16) & 1u)) >> 16; }
typedef float pk_f32x2 __attribute__((ext_vector_type(2))); typedef __bf16 pk_bf16x2 __attribute__((ext_vector_type(2)));
__device__ __forceinline__ unsigned pk2(float lo, float hi) { const pk_f32x2 v = {lo, hi}; const pk_bf16x2 b = __builtin_convertvector(v, pk_bf16x2); return __builtin_bit_cast(unsigned, b); }
__device__ __forceinline__ float bflo(unsigned w) { return __builtin_bit_cast(float, w << 16); }
__device__ __forceinline__ float bfhi(unsigned w) { return __builtin_bit_cast(float, w & 0xffff0000u); }
__device__ __forceinline__ float lane_xchg_(float v, int srclane) { return __builtin_bit_cast(float, __builtin_amdgcn_ds_bpermute(srclane << 2, __builtin_bit_cast(int, v))); }
__device__ __forceinline__ float wave_sum(float v, int lane) {
#pragma unroll
    for (int o = 32; o > 0; o >>= 1) v += lane_xchg_(v, lane ^ o);
    return v;
}
#define XB_TMO      128
#define XB_XCNT(j)  (256  + 64 * (j))
#define XB_XSUB(j)  (1280 + 64 * (j))
#define XB_XGEN(j)  (2304 + 64 * (j))
#define XB_TOP      3328
#define XB_TOPGEN   3392
#define XCD_BAR_WORDS 3456
#define XB_SPIN_CAP (1u << 18)

__device__ __forceinline__ unsigned xb_ld(unsigned* p)              { return __hip_atomic_load(p, __ATOMIC_RELAXED, __HIP_MEMORY_SCOPE_AGENT); }
__device__ __forceinline__ unsigned xb_add(unsigned* p, unsigned v) { return __hip_atomic_fetch_add(p, v, __ATOMIC_RELAXED, __HIP_MEMORY_SCOPE_AGENT); }
__device__ __forceinline__ unsigned xb_xcc_id() { return (unsigned)__builtin_amdgcn_s_getreg((3 << 11) | 20) & 0xFu; }
#define XB_SPIN(cond, bar) do { unsigned _sp = 0; while (cond) { __builtin_amdgcn_s_sleep(1); \
    if ((++_sp & 255u) == 0u) { if (xb_ld(&(bar)[XB_TMO])) break; if (_sp > XB_SPIN_CAP) { atomicAdd(&(bar)[XB_TMO], 1u); break; } } } } while (0)

struct XcdBarrier {
    unsigned* bar; unsigned x;
    volatile LAS unsigned* st;
};

__device__ __forceinline__ XcdBarrier xcd_barrier_post(unsigned* bar, volatile LAS unsigned* st, int tid) {
    XcdBarrier b; b.bar = bar; b.x = xb_xcc_id(); b.st = st;
    if (tid == 0) (void)xb_add(&bar[XB_XCNT(b.x)], 1u);
    return b;
}
__device__ __forceinline__ void xcd_barrier_complete(unsigned* bar, unsigned x, unsigned& nloc, unsigned& nx) {
    const unsigned G = gridDim.x * gridDim.y * gridDim.z;
    unsigned sum, cnt, mine, sp = 0u;
    for (;;) {
        sum = 0u; cnt = 0u; mine = 0u;
#pragma unroll
        for (unsigned j = 0; j < 16; ++j) { const unsigned c = xb_ld(&bar[XB_XCNT(j)]); sum += c; cnt += (c > 0u) ? 1u : 0u; mine = (j == x) ? c : mine; }
        if (sum == G) break;
        __builtin_amdgcn_s_sleep(1);
        if ((++sp & 255u) == 0u) { if (xb_ld(&bar[XB_TMO])) break; if (sp > XB_SPIN_CAP) { atomicAdd(&bar[XB_TMO], 1u); break; } }
    }
    nloc = mine > 0u ? mine : 1u; nx = cnt > 0u ? cnt : 1u;
}

__device__ __forceinline__ void xcd_barrier(const XcdBarrier& b, int tid) {
    asm volatile("s_waitcnt vmcnt(0)" ::: "memory");
    __syncthreads();
    if (tid == 0) {
        unsigned* bar = b.bar;
        __builtin_amdgcn_s_waitcnt(0);
        unsigned nloc = b.st[0], nx = b.st[1];
        if (nloc == 0u) { xcd_barrier_complete(bar, b.x, nloc, nx); b.st[0] = nloc; b.st[1] = nx; }
        const unsigned old = xb_add(&bar[XB_XSUB(b.x)], 1u);
        const unsigned gen = old / nloc;
        if (old + 1u == (gen + 1u) * nloc) {
            __builtin_amdgcn_fence(__ATOMIC_RELEASE, "agent");
            asm volatile("s_waitcnt vmcnt(0)" ::: "memory");
            const unsigned og = xb_add(&bar[XB_TOP], 1u);
            const unsigned tg = og / nx;
            if (og + 1u == (tg + 1u) * nx) xb_add(&bar[XB_TOPGEN], 1u);
            else XB_SPIN(xb_ld(&bar[XB_TOPGEN]) == tg, bar);
            __builtin_amdgcn_fence(__ATOMIC_ACQUIRE, "agent");
            xb_add(&bar[XB_XGEN(b.x)], 1u);
            asm volatile("s_waitcnt vmcnt(0)" ::: "memory");
        } else {
            XB_SPIN(xb_ld(&bar[XB_XGEN(b.x)]) == gen, bar);
            __builtin_amdgcn_fence(__ATOMIC_ACQUIRE, "agent");
            asm volatile("s_waitcnt vmcnt(0)" ::: "memory");
        }
    }
    __syncthreads();
}

constexpr int XBST_OFF = 155392;
__device__ __forceinline__ void gsync(KP kp, LAS unsigned char* lds, int wid0) {
    kp = kp_fresh(kp);
    XcdBarrier b; b.bar = (unsigned*)kp->ws; b.x = xb_xcc_id(); b.st = (volatile LAS unsigned*)(lds + XBST_OFF);
    xcd_barrier(b, tid_fresh(wid0));
}
__device__ __forceinline__ void tail_barrier(unsigned* ctr, int tid, unsigned nwg) {
    asm volatile("s_waitcnt vmcnt(0)" ::: "memory");
    __syncthreads();
    if (tid == 0) {
        __builtin_amdgcn_fence(__ATOMIC_RELEASE, "agent");
        asm volatile("s_waitcnt vmcnt(0)" ::: "memory");
        (void)xb_add(ctr, 1u);
        unsigned sp = 0u;
        while (xb_ld(ctr) < nwg) { __builtin_amdgcn_s_sleep(1); if (++sp > (1u << 22)) break; }
        __builtin_amdgcn_fence(__ATOMIC_ACQUIRE, "agent");
        asm volatile("s_waitcnt vmcnt(0)" ::: "memory");
    }
    __syncthreads();
}
__device__ __forceinline__ bf16* hrow16(unsigned char* ws, int r) { return (bf16*)(ws + WS_H16) + ((size_t)r << 10); }
__device__ __forceinline__ void unpack8(const u32x4 w, float* v) { v[0] = bflo(w.x); v[1] = bfhi(w.x); v[2] = bflo(w.y); v[3] = bfhi(w.y); v[4] = bflo(w.z); v[5] = bfhi(w.z); v[6] = bflo(w.w); v[7] = bfhi(w.w); }

struct WTile { const float* src; bf16* dst; const float* scale; const float* kscale; int K, Nsrc, map, k0, n0; };
__device__ __forceinline__ WTile wtile_decode(KP kp, int ti) {
    constexpr int T_UP = 1408, T_DOWN = 704, T_DQKV = 192, T_UQ = 144, T_UKV = 128, T_O = 256, T_PG = 16;
    constexpr int B1 = 4 * T_UP, B2 = B1 + 4 * T_DOWN, B3 = B2 + 2 * T_DQKV, B4 = B3 + 2 * T_UQ, B5 = B4 + 2 * T_UKV, B6 = B5 + 2 * T_O;
    unsigned char* ws = kp->ws; WTile w; w.scale = nullptr; w.kscale = nullptr; w.map = 0; int nkt, loc;
    if (ti < B1)      { const int l = ti / T_UP; loc = ti % T_UP; w.src = kp->in[14] + (size_t)l * 1024 * 5632; w.dst = (bf16*)(ws + W_UP + l * SZ_UP); w.K = 1024; w.Nsrc = 5632; nkt = 16; w.map = 2; w.kscale = kp->in[4] + l * 1024; }
    else if (ti < B2) { const int q = ti - B1, l = q / T_DOWN; loc = q % T_DOWN; w.src = kp->in[17] + (size_t)l * 2816 * 1024; w.dst = (bf16*)(ws + W_DOWN + l * SZ_DOWN); w.K = 2816; w.Nsrc = 1024; nkt = 44; }
    else if (ti < B3) { const int q = ti - B2, l = q / T_DQKV; loc = q % T_DQKV; w.src = kp->in[6] + (size_t)l * 1024 * 672; w.dst = (bf16*)(ws + W_DQKV + l * SZ_DQKV); w.K = 1024; w.Nsrc = 672; nkt = 16; w.kscale = kp->in[2] + (2 * l) * 1024; }
    else if (ti < B4) { const int q = ti - B3, l = q / T_UQ; loc = q % T_UQ; w.src = kp->in[8] + (size_t)l * 384 * 1536; w.dst = (bf16*)(ws + W_UQ + l * SZ_UQ); w.K = 384; w.Nsrc = 1536; nkt = 6; w.map = 1; w.kscale = kp->in[7] + l * 384; }
    else if (ti < B5) { const int q = ti - B4, l = q / T_UKV; loc = q % T_UKV; w.src = kp->in[10] + (size_t)l * 256 * 2048; w.dst = (bf16*)(ws + W_UKV + l * SZ_UKV); w.K = 256; w.Nsrc = 2048; nkt = 4; w.kscale = kp->in[9] + l * 256; }
    else if (ti < B6) { const int q = ti - B5, l = q / T_O; loc = q % T_O; w.src = kp->in[11] + (size_t)l * 1024 * 1024; w.dst = (bf16*)(ws + W_O + l * SZ_O); w.K = 1024; w.Nsrc = 1024; nkt = 16; }
    else              { const int q = ti - B6, lg = q / T_PG; loc = q % T_PG; w.src = kp->in[12] + (size_t)lg * 256 * 256; w.dst = (bf16*)(ws + W_POOL) + (size_t)lg * 256 * 256; w.K = 256; w.Nsrc = 256; nkt = 4; w.scale = kp->in[13] + lg * 256; w.kscale = kp->in[2] + (2 * (lg >> 2) + 1) * 1024 + (lg & 3) * 256; }
    { const int ntiles_n = (ti < B1 ? T_UP : ti < B2 ? T_DOWN : ti < B3 ? T_DQKV : ti < B4 ? T_UQ : ti < B5 ? T_UKV : ti < B6 ? T_O : T_PG) / nkt;
      w.n0 = (loc % ntiles_n) * 64; w.k0 = (loc / ntiles_n) * 64; }
    return w;
}
__device__ __forceinline__ void wtile_load(const WTile& w, int tid, float (&v)[8]) {
    const int n = w.n0 + (tid & 63);
    int sc;
    if (w.map == 1) sc = n < 1024 ? (n >> 6) * 96 + (n & 63) : ((n - 1024) >> 5) * 96 + 64 + ((n - 1024) & 31);
    else if (w.map == 2) sc = ((n >> 7) & 1) * 2816 + (n >> 8) * 128 + (n & 127);
    else sc = n < w.Nsrc ? n : -1;
    const float s = w.scale ? w.scale[n] : 1.0f;
#pragma unroll
    for (int i = 0; i < 8; ++i) { const int k = i * 8 + (tid >> 6); v[i] = sc >= 0 ? __builtin_nontemporal_load(w.src + (size_t)(w.k0 + k) * w.Nsrc + sc) * s * (w.kscale ? w.kscale[w.k0 + k] : 1.0f) : 0.f; }
}
constexpr int W_TILES = 4 * 1408 + 4 * 704 + 2 * 192 + 2 * 144 + 2 * 128 + 2 * 256 + 8 * 16;
__device__ __forceinline__ void prologue_weights(KP kp, LAS float* tile, int wid0) {
    kp = kp_fresh(kp);
    const int tid = tid_fresh(wid0);
    int ti = blockIdx.x;
    if (ti >= W_TILES) return;
    WTile w = wtile_decode(kp, ti);
    float v[8];
    wtile_load(w, tid, v);
    int par = 0;
    for (;;) {
        LAS float* tb = tile + par * (64 * 65);
#pragma unroll
        for (int i = 0; i < 8; ++i) tb[(i * 8 + (tid >> 6)) * 65 + (tid & 63)] = v[i];
        __syncthreads();
        const int tn = ti + (int)gridDim.x; const bool more = tn < W_TILES;
        WTile wn = w;
        if (more) { wn = wtile_decode(kp, tn); wtile_load(wn, tid, v); }
        {
            const int nl = tid >> 3, kc = tid & 7;
            float o[8];
#pragma unroll
            for (int j = 0; j < 8; ++j) o[j] = tb[(kc * 8 + j) * 65 + nl];
            u32x4 pk; pk.x = pk2(o[0], o[1]); pk.y = pk2(o[2], o[3]); pk.z = pk2(o[4], o[5]); pk.w = pk2(o[6], o[7]);
            *(u32x4*)(w.dst + (size_t)(w.n0 + nl) * w.K + w.k0 + kc * 8) = pk;
        }
        if (!more) break;
        w = wn; ti = tn; par ^= 1;
    }
    __syncthreads();
}

__device__ __forceinline__ void prologue_rope(KP kp, int wid0) {
    kp = kp_fresh(kp); const int tid = tid_fresh(wid0);
    float* rc = (float*)(kp->ws + WS_ROPE); float* rs = rc + LL * 16;
    for (int i = blockIdx.x * 512 + tid; i < LL * 16; i += gridDim.x * 512) {
        const int t = i >> 4, e = i & 15;
        const float ang = (float)t * kp->inv_freq[e];
        const double rev = (double)ang * 0.15915494309189535;
        const float fr = (float)(rev - __builtin_rint(rev));
        rc[i] = __builtin_amdgcn_cosf(fr); rs[i] = __builtin_amdgcn_sinf(fr);
    }
}

__device__ __forceinline__ void row_init(KP kp, int wid0) {
    kp = kp_fresh(kp); const int tid = tid_fresh(wid0); const int lane = tid & 63, wid = tid >> 6;
    unsigned char* ws = kp->ws; const float* xin = kp->in[0]; const float* meta = kp->in[1]; float* rsd = (float*)(ws + WS_RSTD);
    for (int row = blockIdx.x * 8 + wid; row < RR; row += gridDim.x * 8) {
        const int b = row / LL, t = row - b * LL;
        const float* src = t < NMETA ? meta + (size_t)t * DM : xin + ((size_t)b * SEQ + (t - NMETA)) * DM;
        bf16* hp = hrow16(ws, row);
        float ss = 0.f;
#pragma unroll
        for (int c = 0; c < 2; ++c) { const f32x4 v0 = __builtin_nontemporal_load((const f32x4*)(src + c * 512 + lane * 8)), v1 = __builtin_nontemporal_load((const f32x4*)(src + c * 512 + lane * 8 + 4));
            ss += v0[0] * v0[0] + v0[1] * v0[1] + v0[2] * v0[2] + v0[3] * v0[3] + v1[0] * v1[0] + v1[1] * v1[1] + v1[2] * v1[2] + v1[3] * v1[3];
            u32x4 hw; hw.x = pk2(v0[0], v0[1]); hw.y = pk2(v0[2], v0[3]); hw.z = pk2(v1[0], v1[1]); hw.w = pk2(v1[2], v1[3]);
            *(u32x4*)(hp + c * 512 + lane * 8) = hw; }
        ss = wave_sum(ss, lane);
        if (lane == 0) rsd[row] = 1.0f / sqrtf(ss * (1.0f / DM) + NORM_EPS);
    }
}

__device__ __forceinline__ void row_res(KP kp, int gpost_in, int layer, bool has_next, int wid0, int row0, int row1, int b0, int nb, int tailp, bool pooled) {
    kp = kp_fresh(kp); const int tid = tid_fresh(wid0); const int lane = tid & 63, wid = tid >> 6;
    unsigned char* ws = kp->ws; float* out = kp->out; const bf16* MX = (const bf16*)(ws + WS_MX); float* rsd = (float*)(ws + WS_RSTD);
    const float* g_post = kp->in[gpost_in] + layer * DM;
    for (int base = row0 + ((int)blockIdx.x - b0) * 16 + wid; base < row1; base += nb * 16) {
        float m[2][2][8], h[2][2][8]; float ss[2] = {0.f, 0.f};
#pragma unroll
        for (int r = 0; r < 2; ++r) { const int row = base + 8 * r; bf16* hp = hrow16(ws, row);
#pragma unroll
            for (int c = 0; c < 2; ++c) {
                if (tailp) { const bf16* t0 = (const bf16*)(ws + WS_MXT) + (size_t)(row - 128 * 256) * DM + c * 512 + lane * 8; unpack8(*(const u32x4*)t0, m[r][c]);
                    for (int q = 1; q < tailp; ++q) { float m2[8]; unpack8(*(const u32x4*)(t0 + (size_t)q * 256 * 1024), m2);
#pragma unroll
                        for (int j = 0; j < 8; ++j) m[r][c][j] += m2[j]; } }
                else if (pooled) { const int t = row % LL, win = 2 << (c * 2 + (lane >> 5)), cnt = (t + 1) < win ? (t + 1) : win; const bf16* zp = MX + (size_t)row * DM + c * 512 + lane * 8;
                    float z0[8], sum[8]; unpack8(*(const u32x4*)zp, z0);
#pragma unroll
                    for (int j = 0; j < 8; ++j) sum[j] = z0[j];
                    for (int d = 1; d < cnt; ++d) { float zd[8]; unpack8(*(const u32x4*)(zp - (size_t)d * DM), zd);
#pragma unroll
                        for (int j = 0; j < 8; ++j) sum[j] += zd[j]; }
                    const float inv = 1.0f / (float)cnt;
#pragma unroll
                    for (int j = 0; j < 8; ++j) m[r][c][j] = sum[j] * inv - z0[j]; }
                else { const u32x4 w = *(const u32x4*)(MX + (size_t)row * DM + c * 512 + lane * 8); unpack8(w, m[r][c]); }
                unpack8(*(const u32x4*)(hp + c * 512 + lane * 8), h[r][c]);
#pragma unroll
                for (int j = 0; j < 8; ++j) ss[r] += m[r][c][j] * m[r][c][j]; } }
#pragma unroll
        for (int o = 32; o > 0; o >>= 1) { const float a = lane_xchg_(ss[0], lane ^ o), b = lane_xchg_(ss[1], lane ^ o); ss[0] += a; ss[1] += b; }
        float s2[2] = {0.f, 0.f};
#pragma unroll
        for (int r = 0; r < 2; ++r) { const float rstd = 1.0f / sqrtf(ss[r] * (1.0f / DM) + NORM_EPS);
#pragma unroll
            for (int c = 0; c < 2; ++c) { const int col = c * 512 + lane * 8; const f32x4 ga = *(const f32x4*)(g_post + col), gb = *(const f32x4*)(g_post + col + 4);
#pragma unroll
                for (int j = 0; j < 8; ++j) { h[r][c][j] += m[r][c][j] * rstd * (j < 4 ? ga[j & 3] : gb[j & 3]); s2[r] += h[r][c][j] * h[r][c][j]; } } }
        if (has_next) {
#pragma unroll
            for (int o = 32; o > 0; o >>= 1) { const float a = lane_xchg_(s2[0], lane ^ o), b = lane_xchg_(s2[1], lane ^ o); s2[0] += a; s2[1] += b; }
#pragma unroll
            for (int r = 0; r < 2; ++r) { const int row = base + 8 * r; bf16* hp = hrow16(ws, row);
#pragma unroll
                for (int c = 0; c < 2; ++c) { u32x4 hw; hw.x = pk2(h[r][c][0], h[r][c][1]); hw.y = pk2(h[r][c][2], h[r][c][3]); hw.z = pk2(h[r][c][4], h[r][c][5]); hw.w = pk2(h[r][c][6], h[r][c][7]);
                    *(u32x4*)(hp + c * 512 + lane * 8) = hw; }
                if (lane == 0) rsd[row] = 1.0f / sqrtf(s2[r] * (1.0f / DM) + NORM_EPS); }
        } else {
#pragma unroll
            for (int r = 0; r < 2; ++r) { const int row = base + 8 * r; const int b = row / LL, t = row - b * LL;
                if (t >= NMETA) { float* op = out + (((size_t)b * SEQ + (t - NMETA)) << 10);
#pragma unroll
                    for (int c = 0; c < 2; ++c) { const int col = c * 512 + lane * 8;
                        __builtin_nontemporal_store((f32x4){h[r][c][0], h[r][c][1], h[r][c][2], h[r][c][3]}, (f32x4*)(op + col)); __builtin_nontemporal_store((f32x4){h[r][c][4], h[r][c][5], h[r][c][6], h[r][c][7]}, (f32x4*)(op + col + 4)); } } }
        }
    }
}

__device__ __forceinline__ void row_latent(KP kp, int jl, int wid0) {
    kp = kp_fresh(kp); const int tid = tid_fresh(wid0); const int lane = tid & 63, wid = tid >> 6;
    unsigned char* ws = kp->ws; const bf16* T1 = (const bf16*)(ws + WS_T1); bf16* KR = (bf16*)(ws + WS_KR); float* rsq = (float*)(ws + WS_RSQ); float* rsk = (float*)(ws + WS_RSK);
    const float* rc = (const float*)(ws + WS_ROPE); const float* rs = rc + LL * 16;
    (void)jl;
    for (int row = blockIdx.x * 8 + wid; row < RR; row += gridDim.x * 8) {
        const bf16* tp = T1 + (size_t)row * NDQKV;
        float sq = 0.f, sk = 0.f;
#pragma unroll
        for (int i = 0; i < 3; ++i) { const unsigned w = *(const unsigned*)(tp + i * 128 + lane * 2); const float a = bflo(w), b = bfhi(w); sq += a * a + b * b; }
#pragma unroll
        for (int i = 0; i < 2; ++i) { const unsigned w = *(const unsigned*)(tp + 384 + i * 128 + lane * 2); const float a = bflo(w), b = bfhi(w); sk += a * a + b * b; }
        sq = wave_sum(sq, lane); sk = wave_sum(sk, lane);
        if (lane == 0) { rsq[row] = 1.0f / sqrtf(sq * (1.0f / QLR) + NORM_EPS); rsk[row] = 1.0f / sqrtf(sk * (1.0f / KVLR) + NORM_EPS); }
        if (lane < 16) {
            const int t = row % LL;
            const float x1 = __builtin_bit_cast(float, (unsigned)tp[640 + lane] << 16), x2 = __builtin_bit_cast(float, (unsigned)tp[656 + lane] << 16);
            const float c = rc[t * 16 + lane], s = rs[t * 16 + lane];
            KR[(size_t)row * 32 + lane] = (bf16)f2bf(x1 * c - x2 * s); KR[(size_t)row * 32 + 16 + lane] = (bf16)f2bf(x2 * c + x1 * s);
        }
    }
}

namespace att {
constexpr int KPT = 208, VP = 136, KBYTES = 64 * KPT, VBYTES = 64 * VP;
constexpr int VOFF = 2 * KBYTES;
typedef float f32x2 __attribute__((ext_vector_type(2))); typedef __bf16 bf16x2_t __attribute__((ext_vector_type(2)));
__device__ __forceinline__ unsigned cvtpk(float lo, float hi) { const f32x2 v = {lo, hi}; const bf16x2_t b = __builtin_convertvector(v, bf16x2_t); return __builtin_bit_cast(unsigned, b); }

__device__ __forceinline__ void qk_tile(f32x16& s0, f32x16& s1, LAS unsigned char* kb, const bf16x8 (&qr)[6], const f32x16& negm, int r32, int hi) {
    bf16x8 kf[12];
#pragma unroll
    for (int ks = 0; ks < 6; ++ks) { kf[2 * ks] = *(const LAS bf16x8*)(kb + r32 * KPT + ks * 32 + hi * 16); kf[2 * ks + 1] = *(const LAS bf16x8*)(kb + (32 + r32) * KPT + ks * 32 + hi * 16); }
    __builtin_amdgcn_sched_barrier(0);
#pragma unroll
    for (int ks = 0; ks < 6; ++ks) {
        s0 = __builtin_amdgcn_mfma_f32_32x32x16_bf16(kf[2 * ks], qr[ks], ks == 0 ? negm : s0, 0, 0, 0);
        s1 = __builtin_amdgcn_mfma_f32_32x32x16_bf16(kf[2 * ks + 1], qr[ks], ks == 0 ? negm : s1, 0, 0, 0);
    }
}
__device__ __forceinline__ void sm_pv(f32x16& s0, f32x16& s1, f32x16& o0, f32x16& o1, float& m_run, float& l_run, f32x16& negm, LAS unsigned char* vb, bool domask, int kbase, int qm, int r32, int hi) {
    s16x4 vlo[8], vhh[8];
#pragma unroll
    for (int kk = 0; kk < 4; ++kk) { const int koff = 2 * (16 * kk + 4 * hi);
        vlo[2 * kk] = *(const LAS s16x4*)(vb + r32 * VP + koff); vhh[2 * kk] = *(const LAS s16x4*)(vb + r32 * VP + koff + 16);
        vlo[2 * kk + 1] = *(const LAS s16x4*)(vb + (32 + r32) * VP + koff); vhh[2 * kk + 1] = *(const LAS s16x4*)(vb + (32 + r32) * VP + koff + 16); }
    __builtin_amdgcn_sched_barrier(0);
    if (domask) {
        const int kb0 = kbase + 4 * hi;
#pragma unroll
        for (int r = 0; r < 16; ++r) { const int kv = kb0 + (r & 3) + 8 * (r >> 2); if (kv > qm) s0[r] = -INFINITY; if (kv + 32 > qm) s1[r] = -INFINITY; }
    }
    float ma = fmaxf(fmaxf(s0[0], s0[1]), s1[0]), mb = fmaxf(fmaxf(s0[2], s0[3]), s1[1]);
    ma = fmaxf(fmaxf(ma, s1[2]), s1[3]);
#pragma unroll
    for (int r = 4; r < 16; r += 4) { ma = fmaxf(fmaxf(ma, s0[r]), s0[r + 1]); mb = fmaxf(fmaxf(mb, s0[r + 2]), s0[r + 3]); ma = fmaxf(fmaxf(ma, s1[r]), s1[r + 1]); mb = fmaxf(fmaxf(mb, s1[r + 2]), s1[r + 3]); }
    float mx = fmaxf(ma, mb);
    { const auto rr = __builtin_amdgcn_permlane32_swap(__float_as_uint(mx), __float_as_uint(mx), false, false); mx = fmaxf(__uint_as_float(rr[0]), __uint_as_float(rr[1])); }
    if (__builtin_amdgcn_ballot_w64(mx > 8.0f) != 0ull) {
        const float d = fmaxf(mx, 0.0f);
        const float alpha = __builtin_amdgcn_exp2f(-d);
        m_run += d; l_run *= alpha; o0 = o0 * alpha; o1 = o1 * alpha;
        s0 = s0 - d; s1 = s1 - d;
#pragma unroll
        for (int r = 0; r < 16; ++r) negm[r] = -m_run;
    }
    f32x2 ps2 = (f32x2){0.f, 0.f};
#pragma unroll
    for (int r = 0; r < 16; r += 2) { s0[r] = __builtin_amdgcn_exp2f(s0[r]); s0[r + 1] = __builtin_amdgcn_exp2f(s0[r + 1]); s1[r] = __builtin_amdgcn_exp2f(s1[r]); s1[r + 1] = __builtin_amdgcn_exp2f(s1[r + 1]);
        ps2 += (f32x2){s0[r], s0[r + 1]}; ps2 += (f32x2){s1[r], s1[r + 1]}; }
    l_run += ps2[0] + ps2[1];
    u32x4 pw[4];
#pragma unroll
    for (int i = 0; i < 4; ++i) { pw[0][i] = cvtpk(s0[2 * i], s0[2 * i + 1]); pw[1][i] = cvtpk(s0[8 + 2 * i], s0[8 + 2 * i + 1]); pw[2][i] = cvtpk(s1[2 * i], s1[2 * i + 1]); pw[3][i] = cvtpk(s1[8 + 2 * i], s1[8 + 2 * i + 1]); }
#pragma unroll
    for (int kk = 0; kk < 4; ++kk) {
        const bf16x8 pf = __builtin_bit_cast(bf16x8, pw[kk]);
        { const s16x4 lo = vlo[2 * kk], hh = vhh[2 * kk];
          const bf16x8 vf = (bf16x8){lo[0], lo[1], lo[2], lo[3], hh[0], hh[1], hh[2], hh[3]};
          o0 = __builtin_amdgcn_mfma_f32_32x32x16_bf16(vf, pf, o0, 0, 0, 0); }
        { const s16x4 lo = vlo[2 * kk + 1], hh = vhh[2 * kk + 1];
          const bf16x8 vf = (bf16x8){lo[0], lo[1], lo[2], lo[3], hh[0], hh[1], hh[2], hh[3]};
          o1 = __builtin_amdgcn_mfma_f32_32x32x16_bf16(vf, pf, o1, 0, 0, 0); }
    }
}

__device__ __forceinline__ void attn_phase(LAS unsigned char* lds, KP kp, int wid0) {
    kp = kp_fresh(kp); unsigned char* ws = kp->ws;
    const bf16* Q = (const bf16*)(ws + WS_Q); const bf16* KV = (const bf16*)(ws + WS_KV); const bf16* KR = (const bf16*)(ws + WS_KR); bf16* O = (bf16*)(ws + WS_O);
    const int tid = tid_fresh(wid0), lane = tid & 63, wid = tid >> 6, r32 = lane & 31, hi = lane >> 5;
    const int key_l = tid >> 3, c8 = tid & 7;
    const int kp2 = tid >> 4, g4 = tid & 15;
    (void)lane;
    for (int bh = blockIdx.x; bh < NB * NHD; bh += gridDim.x) {
        const int b = bh >> 4, h = bh & 15, rowb = b * LL;
        bf16x8 qr[6];
        u32x4 kregA, rregA = {}, kregB, rregB = {}; u32x2 vaA, vbA, vaB, vbB;
#define ATT_BAR() do { asm volatile("s_waitcnt lgkmcnt(0)" ::: "memory"); __builtin_amdgcn_s_barrier(); asm volatile("" ::: "memory"); } while (0)
#define ATT_LOADQ(qm_) do { const bf16* qp_ = Q + (size_t)(rowb + (qm_)) * 1536; \
            _Pragma("unroll") for (int ks = 0; ks < 4; ++ks) qr[ks] = *(const bf16x8*)(qp_ + h * 64 + ks * 16 + hi * 8); \
            _Pragma("unroll") for (int ks = 0; ks < 2; ++ks) qr[4 + ks] = *(const bf16x8*)(qp_ + 1024 + h * 32 + ks * 16 + hi * 8); } while (0)
#define ATT_LOADK(kt_, S_) do { int grow_ = rowb + 64 * (kt_) + key_l; grow_ = grow_ < RR ? grow_ : RR - 1; \
            kreg##S_ = *(const u32x4*)(KV + (size_t)grow_ * 2048 + h * 128 + c8 * 8); rreg##S_ = *(const u32x4*)(KR + (size_t)grow_ * 32 + (c8 & 3) * 8); } while (0)
#define ATT_LOADV(kt_, S_) do { int g0_ = rowb + 64 * (kt_) + 2 * kp2, g1_ = g0_ + 1; g0_ = g0_ < RR ? g0_ : RR - 1; g1_ = g1_ < RR ? g1_ : RR - 1; \
            va##S_ = *(const u32x2*)(KV + (size_t)g0_ * 2048 + h * 128 + 64 + g4 * 4); vb##S_ = *(const u32x2*)(KV + (size_t)g1_ * 2048 + h * 128 + 64 + g4 * 4); } while (0)
#define ATT_STOREK(slot_, S_) do { LAS unsigned char* kb_ = lds + (slot_) * KBYTES; \
            *(LAS u32x4*)(kb_ + key_l * KPT + c8 * 16) = kreg##S_; if (c8 < 4) *(LAS u32x4*)(kb_ + key_l * KPT + 128 + c8 * 16) = rreg##S_; } while (0)
#define ATT_STOREV(slot_, S_) do { LAS unsigned char* vb_ = lds + VOFF + (slot_) * VBYTES + (g4 * 4) * VP + kp2 * 4;     \
            *(LAS unsigned*)(vb_) = (va##S_.x & 0xffffu) | (vb##S_.x << 16); *(LAS unsigned*)(vb_ + VP) = (va##S_.x >> 16) | (vb##S_.x & 0xffff0000u); \
            *(LAS unsigned*)(vb_ + 2 * VP) = (va##S_.y & 0xffffu) | (vb##S_.y << 16); *(LAS unsigned*)(vb_ + 3 * VP) = (va##S_.y >> 16) | (vb##S_.y & 0xffff0000u); } while (0)
#define ATT_ITER(kt_, SA_, SB_, P_) do { const int kt = (kt_); const int tl_ = kt + 2 < NT ? kt + 2 : kt + 2 - NT; \
            ATT_LOADK(tl_, SB_); ATT_LOADV(tl_, SB_);     \
            if (64 * kt <= qwmax) { f32x16 sc0, sc1; \
                qk_tile(sc0, sc1, lds + ((kt + (P_)) & 1) * KBYTES, qr, negm, r32, hi); \
                sm_pv(sc0, sc1, o0, o1, m_run, l_run, negm, lds + VOFF + ((kt + (P_)) & 1) * VBYTES, 64 * kt + 63 > qwmin, 64 * kt, qm, r32, hi); } \
            ATT_STOREK((kt + 1 + (P_)) & 1, SA_); ATT_STOREV((kt + 1 + (P_)) & 1, SA_); \
            ATT_BAR(); } while (0)
        {
            const int qm0 = -240 + 32 * wid + r32;
            ATT_LOADQ(qm0 < 0 ? 0 : qm0);
            ATT_LOADK(0, A); ATT_LOADV(0, A);
            ATT_STOREK(0, A); ATT_STOREV(0, A);
            ATT_LOADK(0, A); ATT_LOADV(0, A);
            ATT_BAR();
        }
        for (int j = 0; j < 9; ++j) {
            const int q0 = j == 0 ? -240 : 16 + 256 * (j - 1);
            const int NT = (q0 + 256 + 63) >> 6;
            const int qw0 = q0 + 32 * wid, q = qw0 + r32, qm = q < 0 ? 0 : q;
            const int qwmax = (qw0 + 31) < 0 ? 0 : (qw0 + 31), qwmin = qw0 < 0 ? 0 : qw0;
            float m_run = 0.f, l_run = 0.f;
            f32x16 o0 = {}, o1 = {}, negm = {};
            if ((j & 1) == 0) {
                for (int kt2 = 0; kt2 < NT; kt2 += 2) { ATT_ITER(kt2, A, B, 0); if (kt2 + 1 < NT) ATT_ITER(kt2 + 1, B, A, 0); }
            } else {
                for (int kt2 = 0; kt2 < NT; kt2 += 2) { ATT_ITER(kt2, B, A, 1); if (kt2 + 1 < NT) ATT_ITER(kt2 + 1, A, B, 1); }
            }
            if (j < 8) { const int qn = 16 + 256 * j + 32 * wid + r32; ATT_LOADQ(qn); }
            { const auto rr = __builtin_amdgcn_permlane32_swap(__float_as_uint(l_run), __float_as_uint(l_run), false, false); l_run = __uint_as_float(rr[0]) + __uint_as_float(rr[1]); }
            {
                const float inv = 1.0f / l_run;
                LAS unsigned char* stg = lds + 45056 + wid * 4608;
#pragma unroll
                for (int g = 0; g < 4; ++g) {
                    u32x2 w; w.x = cvtpk(o0[4 * g] * inv, o0[4 * g + 1] * inv); w.y = cvtpk(o0[4 * g + 2] * inv, o0[4 * g + 3] * inv); *(LAS u32x2*)(stg + r32 * 144 + (8 * g + 4 * hi) * 2) = w;
                    w.x = cvtpk(o1[4 * g] * inv, o1[4 * g + 1] * inv); w.y = cvtpk(o1[4 * g + 2] * inv, o1[4 * g + 3] * inv); *(LAS u32x2*)(stg + r32 * 144 + 64 + (8 * g + 4 * hi) * 2) = w;
                }
                asm volatile("s_waitcnt lgkmcnt(0)" ::: "memory");
#pragma unroll
                for (int i = 0; i < 4; ++i) {
                    const int row = i * 8 + (lane >> 3), ch = lane & 7, qq = qw0 + row;
                    const u32x4 v = *(const LAS u32x4*)(stg + row * 144 + ch * 16);
                    if (qq >= 0) *(u32x4*)(O + (size_t)(rowb + qq) * DM + h * 64 + ch * 8) = v;
                }
                asm volatile("s_waitcnt lgkmcnt(0)" ::: "memory");
            }
        }
#undef ATT_ITER
#undef ATT_BAR
#undef ATT_LOADQ
#undef ATT_LOADK
#undef ATT_LOADV
#undef ATT_STOREK
#undef ATT_STOREV
    }
}
}

__global__ void __launch_bounds__(512, 2) hybrid_fwd(Params p_unused) {
    extern __shared__ __attribute__((aligned(16))) unsigned char lds_raw[];
    LAS unsigned char* lds = (LAS unsigned char*)lds_raw;
    cg::grid_group grid = cg::this_grid();
    const KP kp0 = (KP)__builtin_amdgcn_kernarg_segment_ptr();
    const int G = (int)gridDim.x, bid = (int)blockIdx.x;
    const int wid0 = __builtin_amdgcn_readfirstlane((int)threadIdx.x >> 6);

#define GSYNC() gsync(kp0, lds, wid0)
    {
        const int t0 = tid_fresh(wid0);
        if (t0 < 4) ((LAS unsigned*)(lds + XBST_OFF))[t0] = 0u;
        __syncthreads();
        (void)xcd_barrier_post((unsigned*)kp0->ws, (volatile LAS unsigned*)(lds + XBST_OFF), t0);
    }
    prologue_weights(kp0, (LAS float*)lds, wid0);
    prologue_rope(kp0, wid0);
    row_init(kp0, wid0);
    grid.sync();

#pragma unroll 1
    for (int layer = 0; layer < DEPTH; ++layer) {
        const int jl = layer >> 1;
        if ((layer & 1) == 0) {
            {
                unsigned char* ws = kp_fresh(kp0)->ws;
                pg8::Gemm g{(const bf16*)(ws + WS_H16), (const bf16*)(ws + W_DQKV + jl * SZ_DQKV), 1024, 1024, 0, 256, 0, 1024}; int Gq = G, bq = bid; asm volatile("" : "+s"(Gq), "+s"(bq));
                pg8::StaticOrder S; S.init(RR, NDQKV, Gq, bq);
                pg8::EpiT1 E{(bf16*)(ws + WS_T1), (const float*)(ws + WS_RSTD), (float*)(ws + WS_PS)};
                pg8::gemm_phase<pg8::EpiT1, pg8::StaticOrder, true, true>(lds, g, S, E, wid0);
            }
            GSYNC();
            {
                unsigned char* ws = kp_fresh(kp0)->ws;
                const float* rcos = (const float*)(ws + WS_ROPE);
                pg8::Gemm g{(const bf16*)(ws + WS_T1), (const bf16*)(ws + W_UQ + jl * SZ_UQ), QLR, NDQKV, 0, 256, 0, QLR}; pg8::StaticOrder S; S.init(RR, 1536, G, bid);
                pg8::EpiQ E{(bf16*)(ws + WS_Q), rcos, rcos + LL * 16, (const float*)(ws + WS_PS), 0.10206207261596577f * 1.4426950408889634f, LL};
                pg8::gemm_phase<pg8::EpiQ, pg8::StaticOrder, true, true>(lds, g, S, E, wid0);
            }
            {
                unsigned char* ws = kp_fresh(kp0)->ws;
                pg8::Gemm g{(const bf16*)(ws + WS_T1) + QLR, (const bf16*)(ws + W_UKV + jl * SZ_UKV), KVLR, NDQKV, 0, 256, 0, KVLR}; pg8::StaticOrder S; S.init(RR, 2048, G, (bid + G / 2) % G);
                pg8::EpiStore E{(bf16*)(ws + WS_KV), 2048, (const float*)(ws + WS_PS), (float)KVLR, (const bf16*)(ws + WS_T1) + 640, (bf16*)(ws + WS_KR), (const float*)(ws + WS_ROPE), LL};
                pg8::gemm_phase<pg8::EpiStore, pg8::StaticOrder, true, true>(lds, g, S, E, wid0);
            }
            GSYNC();
            att::attn_phase(lds, kp0, wid0);
            GSYNC();
        }
#pragma unroll 1
        for (int half = 0; half < 2; ++half) {
            if (half == 1) {
                {
                    const KP kp = kp_fresh(kp0); unsigned char* ws = kp->ws;
                    pg8::Gemm g{(const bf16*)(ws + WS_H16), (const bf16*)(ws + W_UP + layer * SZ_UP), 1024, 1024, -2, UP_RSTEP, 0, 1024}; pg8::StaticOrder S; S.init(UP_TILES_M * 256, 5632, G, bid, 4);
                    pg8::EpiConv E{(bf16*)(ws + WS_G), kp->in[15] + (size_t)layer * 3 * 5632, kp->in[16] + (size_t)layer * 5632, (const float*)(ws + WS_RSTD), (LAS f32x4*)(lds + XCH_OFF), (LAS float*)(lds + XCH_OFF + 8192), (LAS float*)(lds + XCH_OFF + 8192 + 8192), -2, UP_RSTEP, RR, LL};
                    pg8::gemm_phase<pg8::EpiConv, pg8::StaticOrder, true, true>(lds, g, S, E, wid0);
                }
                GSYNC();
            }
            pg8::Gemm g;
            {
                unsigned char* ws = kp_fresh(kp0)->ws;
                if (half == 1)              g = pg8::Gemm{(const bf16*)(ws + WS_G), (const bf16*)(ws + W_DOWN + layer * SZ_DOWN), DFF, DFF, 0, 256, 0, DFF};
                else if ((layer & 1) == 0)  g = pg8::Gemm{(const bf16*)(ws + WS_O), (const bf16*)(ws + W_O + jl * SZ_O), 1024, 1024, 0, 256, 0, 1024};
                else                        g = pg8::Gemm{(const bf16*)(ws + WS_H16), (const bf16*)(ws + W_POOL + jl * SZ_POOL), 256, 1024, 0, 256, 512, 256};
            }
            {
                pg8::StaticOrder S; S.init(128 * 256, 1024, G, bid);
                unsigned char* ws = kp_fresh(kp0)->ws;
                pg8::EpiStore E{(bf16*)(ws + WS_MX), 1024, (half == 0 && (layer & 1)) ? (const float*)(ws + WS_RSTD) : nullptr, 0.f, nullptr, nullptr, nullptr, LL};
                pg8::gemm_phase<pg8::EpiStore, pg8::StaticOrder, true, true>(lds, g, S, E, wid0);
            }
            GSYNC();
            const int gpi = half == 0 ? 3 : 5; const bool hn = half == 0 ? true : (layer + 1 < DEPTH);
            const int ntail = half == 1 ? 8 : 4;
            if (bid < ntail) {
                const int ks = bid >> 2;
                unsigned char* ws = kp_fresh(kp0)->ws;
                pg8::Gemm gt = g; bf16* mxo = (bf16*)(ws + WS_MX);
                if (half == 1) { gt.A = g.A + ks * (DFF / 2); gt.Bt = g.Bt + ks * (DFF / 2); gt.K = DFF / 2; mxo = (bf16*)(ws + WS_MXT) + (size_t)ks * 256 * 1024 - (size_t)128 * 256 * 1024; }
                pg8::TailOrder S{128, 4, bid & 3};
                pg8::EpiStore E{mxo, 1024, (half == 0 && (layer & 1)) ? (const float*)(ws + WS_RSTD) : nullptr, 0.f, nullptr, nullptr, nullptr, LL};
                pg8::gemm_phase<pg8::EpiStore, pg8::TailOrder, true, true>(lds, gt, S, E, wid0);
                tail_barrier((unsigned*)kp_fresh(kp0)->ws + 3584 + 64 * (layer * 2 + half), tid_fresh(wid0), (unsigned)ntail);
                const int rpb = 256 / ntail;
                row_res(kp0, gpi, layer, hn, wid0, 128 * 256 + rpb * bid, 128 * 256 + rpb * bid + rpb, bid, 1, half == 1 ? 2 : 0, half == 0 && (layer & 1));
            } else {
                row_res(kp0, gpi, layer, hn, wid0, 0, 128 * 256, ntail, G - ntail, 0, half == 0 && (layer & 1));
            }
            if (!(half == 1 && layer + 1 == DEPTH)) GSYNC();
        }
    }
}

extern "C" void kernel_launch(void* const* d_in, const int* in_sizes, int n_in, void* d_out, int out_size, void* d_ws, size_t ws_size, hipStream_t stream) {
    static int grid = 0;
    if (grid == 0) {
        if (n_in != 18 || out_size != NB * SEQ * DM || ws_size < WS_END) { fprintf(stderr, "kernel_launch: unexpected problem (n_in %d out %d ws %zu need %zu)\n", n_in, out_size, ws_size, (size_t)WS_END); grid = -1; return; }
        int dev = 0, cus = 0, per_cu = 0;
        (void)hipGetDevice(&dev);
        (void)hipDeviceGetAttribute(&cus, hipDeviceAttributeMultiprocessorCount, dev);
        if (hipFuncSetAttribute((const void*)hybrid_fwd, hipFuncAttributeMaxDynamicSharedMemorySize, LDS_BYTES) != hipSuccess) { fprintf(stderr, "kernel_launch: hipFuncSetAttribute failed\n"); }
        if (hipOccupancyMaxActiveBlocksPerMultiprocessor(&per_cu, (const void*)hybrid_fwd, 512, LDS_BYTES) != hipSuccess || per_cu < 1) { fprintf(stderr, "kernel_launch: occupancy query says %d\n", per_cu); per_cu = 1; }
        (void)hipGetLastError();
        grid = cus * per_cu;
        if (grid > 256) grid = 256;
        if (grid < 1) grid = 256;
    }
    if (grid < 0) return;
    Params p{};
    for (int i = 0; i < 18; ++i) p.in[i] = (const float*)d_in[i];
    p.out = (float*)d_out; p.ws = (unsigned char*)d_ws;
    for (int e = 0; e < 16; ++e) p.inv_freq[e] = 1.0f / powf(10000.0f, (float)(2 * e) / 32.0f);
    if (hipMemsetAsync(d_ws, 0, 16384, stream) != hipSuccess) fprintf(stderr, "kernel_launch: memset of the barrier words failed\n");
    void* args[] = {&p};
    hipError_t e = hipLaunchCooperativeKernel((const void*)hybrid_fwd, dim3(grid), dim3(512), args, LDS_BYTES, stream);
    if (e != hipSuccess) fprintf(stderr, "cooperative launch failed: %s (grid %d)\n", hipGetErrorString(e), grid);
}
```
